# Optimizing an MI355X kernel written in HIP

```python
import math
import jax, jax.numpy as jnp
from jax import lax
import numpy as np

D_MODEL = 2048
BATCH = 4
SEQ = 4096
DEPTH = 2

N_MIXERS = 2
HEAD_DIM = 128
N_HEADS = D_MODEL // (2 * HEAD_DIM)
V_DIM = 2 * HEAD_DIM
QKV_DIM = 2 * N_HEADS * HEAD_DIM * 2 + N_HEADS * V_DIM
ROT_DIM = HEAD_DIM // 4
ROPE_THETA = 500000.0
Q_BLOCK = 128
SSM_GROUP = 16
N_GROUPS = D_MODEL // SSM_GROUP
SSM_STATE = 64
SSM_CHUNK = 128
D_FF = 256 * ((8 * D_MODEL // 3 + 255) // 256)
N_SUBLAYERS = 3
N_ATTN_LAYERS = (DEPTH + 1) // 2
N_SSM_LAYERS = DEPTH // 2
NORM_EPS = 1e-6
MACARON_WEIGHT = 0.5

kernel_name = "hybrid_diffattn_s5_macaron_adaln"


def rms_norm(x, g):
    xf = x.astype(jnp.float32)
    y = xf * lax.rsqrt(jnp.mean(xf * xf, axis=-1, keepdims=True) + NORM_EPS)
    return (y * g.astype(jnp.float32)).astype(x.dtype)


def rope_tables(positions):
    inv_freq = ROPE_THETA ** (-jnp.arange(0, ROT_DIM, 2, dtype=jnp.float32) / ROT_DIM)
    ang = positions.astype(jnp.float32)[..., None] * inv_freq
    return jnp.cos(ang), jnp.sin(ang)


def apply_partial_rope(t, cos, sin):
    cos = cos[:, None, None]
    sin = sin[:, None, None]
    tf = t.astype(jnp.float32)
    half = ROT_DIM // 2
    r1 = tf[..., :half]
    r2 = tf[..., half:ROT_DIM]
    out = jnp.concatenate([r1 * cos - r2 * sin, r2 * cos + r1 * sin, tf[..., ROT_DIM:]], axis=-1)
    return out.astype(t.dtype)


def swiglu(h, w_in, w_out):
    a, b = jnp.split(h @ w_in, 2, axis=-1)
    return (jax.nn.silu(a) * b) @ w_out


def diff_attention(h, w_in, w_out, q_g, k_g, lam_vec, subln_g, cos, sin, lambda_init):
    bsz, seq, _ = h.shape
    qkv = h @ w_in
    qd = 2 * N_HEADS * HEAD_DIM
    q, k, v = jnp.split(qkv, [qd, 2 * qd], axis=-1)
    q = q.reshape(bsz, seq, N_HEADS, 2, HEAD_DIM).transpose(0, 2, 3, 1, 4)
    k = k.reshape(bsz, seq, N_HEADS, 2, HEAD_DIM).transpose(0, 2, 3, 1, 4)
    v = v.reshape(bsz, seq, N_HEADS, V_DIM).transpose(0, 2, 1, 3)
    q = apply_partial_rope(rms_norm(q, q_g), cos, sin)
    k = apply_partial_rope(rms_norm(k, k_g), cos, sin)
    lv = lam_vec.astype(jnp.float32)
    lam = jnp.exp(jnp.sum(lv[0] * lv[1])) - jnp.exp(jnp.sum(lv[2] * lv[3])) + lambda_init
    scale = HEAD_DIM ** -0.5
    n_blocks = seq // Q_BLOCK
    q_blocks = q.reshape(bsz, N_HEADS, 2, n_blocks, Q_BLOCK, HEAD_DIM).transpose(3, 0, 1, 2, 4, 5)
    k_pos = jnp.arange(seq)

    def one_block(args):
        q_blk, blk = args
        s = jnp.einsum('bhcqd,bhckd->bhcqk', q_blk, k, preferred_element_type=jnp.float32) * scale
        q_pos = blk * Q_BLOCK + jnp.arange(Q_BLOCK)
        mask = k_pos[None, :] <= q_pos[:, None]
        p = jax.nn.softmax(jnp.where(mask, s, -jnp.inf), axis=-1)
        attn = p[:, :, 0] - lam * p[:, :, 1]
        return jnp.einsum('bhqk,bhkv->bhqv', attn.astype(v.dtype), v)

    o = lax.map(one_block, (q_blocks, jnp.arange(n_blocks)))
    o = o.transpose(1, 2, 0, 3, 4).reshape(bsz, N_HEADS, seq, V_DIM)
    o = rms_norm(o, subln_g) * (1.0 - lambda_init)
    o = o.transpose(0, 2, 1, 3).reshape(bsz, seq, N_HEADS * V_DIM)
    return o @ w_out


def _ssm_combine(e1, e2):
    a1r, a1i, b1r, b1i = e1
    a2r, a2i, b2r, b2i = e2
    return (a2r * a1r - a2i * a1i,
            a2r * a1i + a2i * a1r,
            a2r * b1r - a2i * b1i + b2r,
            a2r * b1i + a2i * b1r + b2i)


def s5_glu_mixer(h, a_re, a_im, log_step, b_re, b_im, c_re, c_im, d_skip, w_glu):
    bsz, seq, _ = h.shape
    f32 = jnp.float32
    u = h.astype(f32).reshape(bsz, seq, N_GROUPS, SSM_GROUP)
    ar = a_re.astype(f32)
    ai = a_im.astype(f32)
    dt = jnp.exp(log_step.astype(f32))[:, None]
    mag = jnp.exp(dt * ar)
    abar_re = mag * jnp.cos(dt * ai)
    abar_im = mag * jnp.sin(dt * ai)
    den = ar * ar + ai * ai
    num_re = abar_re - 1.0
    coef_re = (num_re * ar + abar_im * ai) / den
    coef_im = (abar_im * ar - num_re * ai) / den
    br = b_re.astype(f32)
    bi = b_im.astype(f32)
    bbar_re = coef_re[..., None] * br - coef_im[..., None] * bi
    bbar_im = coef_re[..., None] * bi + coef_im[..., None] * br
    cr = c_re.astype(f32)
    ci = c_im.astype(f32)
    n_chunks = seq // SSM_CHUNK
    u_chunks = u.reshape(bsz, n_chunks, SSM_CHUNK, N_GROUPS, SSM_GROUP).transpose(1, 2, 0, 3, 4)
    a_shape = (SSM_CHUNK, bsz, N_GROUPS, SSM_STATE)
    abar_re_b = jnp.broadcast_to(abar_re, a_shape)
    abar_im_b = jnp.broadcast_to(abar_im, a_shape)

    def chunk_step(carry, u_c):
        h_re, h_im = carry
        bu_re = jnp.einsum('tbgp,gnp->tbgn', u_c, bbar_re)
        bu_im = jnp.einsum('tbgp,gnp->tbgn', u_c, bbar_im)
        p_re, p_im, l_re, l_im = lax.associative_scan(
            _ssm_combine, (abar_re_b, abar_im_b, bu_re, bu_im), axis=0)
        s_re = l_re + p_re * h_re - p_im * h_im
        s_im = l_im + p_re * h_im + p_im * h_re
        y_c = jnp.einsum('tbgn,gpn->tbgp', s_re, cr) - jnp.einsum('tbgn,gpn->tbgp', s_im, ci)
        return (s_re[-1], s_im[-1]), y_c

    zeros = jnp.zeros((bsz, N_GROUPS, SSM_STATE), f32)
    _, y = lax.scan(chunk_step, (zeros, zeros), u_chunks)
    y = y.transpose(2, 0, 1, 3, 4).reshape(bsz, seq, D_MODEL)
    y = y + d_skip.astype(f32) * h.astype(f32)
    z = jax.nn.gelu(y).astype(h.dtype)
    val, gate = jnp.split(z @ w_glu, 2, axis=-1)
    return val * jax.nn.sigmoid(gate)


def setup_inputs(seed: int = 0) -> dict:
    key = jax.random.key(seed)
    ks = jax.random.split(key, 24)
    f32 = jnp.float32
    D, F = D_MODEL, D_FF
    nrm = lambda k, shape, s: jax.random.normal(k, shape, f32) * s
    x = jax.random.normal(ks[0], (BATCH, SEQ, D), f32)
    c = jax.random.normal(ks[1], (BATCH, D), f32)
    offsets = jax.random.randint(ks[2], (BATCH, 1), 0, 1024, dtype=jnp.int32)
    positions = offsets + jnp.arange(SEQ, dtype=jnp.int32)[None, :]
    norm_g = 1.0 + nrm(ks[3], (DEPTH, N_SUBLAYERS, D), 0.02)
    ada_w = nrm(ks[4], (DEPTH, D, N_SUBLAYERS * 3 * D), 0.5 * D ** -0.5)
    ada_b = nrm(ks[5], (DEPTH, N_SUBLAYERS * 3 * D), 0.02)
    ffn_w_in = nrm(ks[6], (DEPTH, 2, D, 2 * F), D ** -0.5)
    ffn_w_out = nrm(ks[7], (DEPTH, 2, F, D), F ** -0.5)
    attn_w_in = nrm(ks[8], (N_ATTN_LAYERS, D, QKV_DIM), D ** -0.5)
    attn_w_out = nrm(ks[9], (N_ATTN_LAYERS, N_HEADS * V_DIM, D), (N_HEADS * V_DIM) ** -0.5)
    attn_q_norm = 1.0 + nrm(ks[10], (N_ATTN_LAYERS, HEAD_DIM), 0.02)
    attn_k_norm = 1.0 + nrm(ks[11], (N_ATTN_LAYERS, HEAD_DIM), 0.02)
    attn_lambda = nrm(ks[12], (N_ATTN_LAYERS, 4, HEAD_DIM), 0.1)
    attn_subln = 1.0 + nrm(ks[13], (N_ATTN_LAYERS, V_DIM), 0.02)
    ssm_a_re = -0.5 + nrm(ks[14], (N_SSM_LAYERS, N_GROUPS, SSM_STATE), 0.01)
    ssm_a_im = jnp.broadcast_to(math.pi * jnp.arange(SSM_STATE, dtype=f32),
                                (N_SSM_LAYERS, N_GROUPS, SSM_STATE))
    ssm_log_step = jax.random.uniform(ks[15], (N_SSM_LAYERS, N_GROUPS), f32,
                                      math.log(1e-3), math.log(1e-1))
    b_s = (0.5 / SSM_GROUP) ** 0.5
    c_s = (0.5 / SSM_STATE) ** 0.5
    ssm_b_re = nrm(ks[16], (N_SSM_LAYERS, N_GROUPS, SSM_STATE, SSM_GROUP), b_s)
    ssm_b_im = nrm(ks[17], (N_SSM_LAYERS, N_GROUPS, SSM_STATE, SSM_GROUP), b_s)
    ssm_c_re = nrm(ks[18], (N_SSM_LAYERS, N_GROUPS, SSM_GROUP, SSM_STATE), c_s)
    ssm_c_im = nrm(ks[19], (N_SSM_LAYERS, N_GROUPS, SSM_GROUP, SSM_STATE), c_s)
    ssm_d = nrm(ks[20], (N_SSM_LAYERS, D), 1.0)
    ssm_w_glu = nrm(ks[21], (N_SSM_LAYERS, D, 2 * D), D ** -0.5)
    return {"x": x, "c": c, "positions": positions, "norm_g": norm_g,
            "ada_w": ada_w, "ada_b": ada_b, "ffn_w_in": ffn_w_in, "ffn_w_out": ffn_w_out,
            "attn_w_in": attn_w_in, "attn_w_out": attn_w_out, "attn_q_norm": attn_q_norm,
            "attn_k_norm": attn_k_norm, "attn_lambda": attn_lambda, "attn_subln": attn_subln,
            "ssm_a_re": ssm_a_re, "ssm_a_im": ssm_a_im, "ssm_log_step": ssm_log_step,
            "ssm_b_re": ssm_b_re, "ssm_b_im": ssm_b_im, "ssm_c_re": ssm_c_re,
            "ssm_c_im": ssm_c_im, "ssm_d": ssm_d, "ssm_w_glu": ssm_w_glu}


def reference(x, c, positions, norm_g, ada_w, ada_b, ffn_w_in, ffn_w_out,
              attn_w_in, attn_w_out, attn_q_norm, attn_k_norm, attn_lambda, attn_subln,
              ssm_a_re, ssm_a_im, ssm_log_step, ssm_b_re, ssm_b_im, ssm_c_re,
              ssm_c_im, ssm_d, ssm_w_glu):
    bsz = x.shape[0]
    cos, sin = rope_tables(positions)
    cond = jax.nn.silu(c)
    for i in range(DEPTH):
        mod = (cond @ ada_w[i] + ada_b[i]).reshape(bsz, N_SUBLAYERS, 3, D_MODEL)
        shift = mod[:, :, 0][:, :, None, :]
        scale = mod[:, :, 1][:, :, None, :]
        gate = mod[:, :, 2][:, :, None, :]

        h = rms_norm(x, norm_g[i, 0]) * (1.0 + scale[:, 0]) + shift[:, 0]
        x = x + MACARON_WEIGHT * gate[:, 0] * swiglu(h, ffn_w_in[i, 0], ffn_w_out[i, 0])

        h = rms_norm(x, norm_g[i, 1]) * (1.0 + scale[:, 1]) + shift[:, 1]
        j = i // N_MIXERS
        if i % N_MIXERS == 0:
            lambda_init = 0.8 - 0.6 * math.exp(-0.3 * i)
            m = diff_attention(h, attn_w_in[j], attn_w_out[j], attn_q_norm[j], attn_k_norm[j],
                               attn_lambda[j], attn_subln[j], cos, sin, lambda_init)
        else:
            m = s5_glu_mixer(h, ssm_a_re[j], ssm_a_im[j], ssm_log_step[j], ssm_b_re[j],
                             ssm_b_im[j], ssm_c_re[j], ssm_c_im[j], ssm_d[j], ssm_w_glu[j])
        x = x + gate[:, 1] * m

        h = rms_norm(x, norm_g[i, 2]) * (1.0 + scale[:, 2]) + shift[:, 2]
        x = x + MACARON_WEIGHT * gate[:, 2] * swiglu(h, ffn_w_in[i, 1], ffn_w_out[i, 1])
    return x
```

```cpp
#include <hip/hip_runtime.h>
#include <hip/hip_bf16.h>
#include <cstdio>
#include <cstdint>
__device__ __forceinline__ int ptid() { int t = threadIdx.x; asm volatile("" : "+v"(t)); return t; }
#ifndef PG8_USE_SP2
#define PG8_USE_SP2 1
#endif
namespace pg8 {
#define PG8_LAS __attribute__((address_space(3)))
typedef unsigned short bf16_t;
typedef short bf16x8 __attribute__((ext_vector_type(8)));
typedef float f32x4 __attribute__((ext_vector_type(4)));
typedef float f32x2 __attribute__((ext_vector_type(2)));
typedef unsigned u32x4 __attribute__((ext_vector_type(4)));
constexpr int BM = 256, BK = 64, HALF = 128, HTB = HALF * BK * 2  , STAGE_BYTES = 8 * HTB, NXCD = 8, WGM = 8;

__host__ __device__ __forceinline__ int lds_byte(int r, int c) { const int st = (r >> 4) * 2 + (c >> 5), rr = r & 15, cc = c & 31, ob = rr * 64 + cc * 2; return st * 1024 + (ob ^ (((ob >> 9) & 1) << 5)); }
__host__ __device__ __forceinline__ void stage_rc(int b, int& R, int& C) { const int st = b / 1024, sb = b % 1024, swz = sb ^ (((sb >> 9) & 1) << 5); R = (st >> 1) * 16 + swz / 64; C = (st & 1) * 32 + (swz % 64) / 2; }
__host__ __device__ __forceinline__ int perm32(int rho) { const int n = rho >> 4, i = rho & 15; return 8 * (i >> 2) + 4 * n + (i & 3); }

struct Unit { int pm, pn; };
struct Gemm { const bf16_t* A; const bf16_t* Bt; int M, N, K, lda, ldb, grp; int krev = 0; };

struct StaticOrder {
    int nM, nN, nwg, G, c, wgm, i0 = 0, i1 = 1 << 30, nrev = 0  , mrev = 0;
    __host__ __device__ void init(int M, int N, int G_, int c_, int wgm_ = WGM) { nM = M / BM; nN = N / BM; nwg = nM * nN; G = G_; c = c_; wgm = wgm_; }
    __host__ __device__ bool next(int i_, Unit& u) const {
        const int i = i_ + i0; if (i >= i1) return false;
        const long L = (long)i * G + c; if (L >= nwg) return false;
        int wgid = (int)L; { const int q = nwg / NXCD, r = nwg % NXCD, xcd = wgid % NXCD, off = wgid / NXCD; wgid = (xcd < r ? xcd * (q + 1) : r * (q + 1) + (xcd - r) * q) + off; }
        const int nig = wgm * nN, gid = wgid / nig, fm = gid * wgm, gsz = (nM - fm) < wgm ? (nM - fm) : wgm;
        u.pm = fm + ((wgid % nig) % gsz); u.pn = (wgid % nig) / gsz; if (mrev == 1) u.pm = nM - 1 - u.pm; else if (mrev == 2) u.pm = (u.pm + nM / 2) % nM; else if (mrev == 3) u.pm = (u.pm & ~7) | (7 - (u.pm & 7)); if (nrev) u.pn = nN - 1 - u.pn; return true;
    }
};

__device__ __forceinline__ unsigned cvt_pk_bf16(float lo, float hi) { unsigned r; asm volatile("v_cvt_pk_bf16_f32 %0, %1, %2" : "=v"(r) : "v"(lo), "v"(hi)); return r; }
__device__ __forceinline__ float sigmoidf_fast(float v) { return __builtin_amdgcn_rcpf(1.0f + __builtin_amdgcn_exp2f(-1.4426950408889634f * v)); }

struct EpiSwiGLU {
    static constexpr bool PERM = true;
    bf16_t* O; int ldc;
    __device__ __forceinline__ void operator()(const f32x4 (&acc)[2][2][4][2], const Unit& u, int wr, int wc, int fr, int fq) const {
        asm volatile("" : "+v"(fr), "+v"(fq));
        const int row0 = u.pm * BM + wr * 64 + fr, col0 = u.pn * HALF + wc * 32 + 8 * fq;
#pragma unroll
        for (int ai = 0; ai < 2; ++ai)
#pragma unroll
            for (int m = 0; m < 4; ++m) { bf16_t* rowp = O + (size_t)(row0 + ai * HALF + m * 16) * ldc + col0;
                float r[8];
#pragma unroll
                for (int n = 0; n < 2; ++n)
#pragma unroll
                    for (int j = 0; j < 4; ++j) { const float a = acc[ai][0][m][n][j], b = acc[ai][1][m][n][j]; r[n * 4 + j] = a * sigmoidf_fast(a) * b; }
                u32x4 w; w.x = cvt_pk_bf16(r[0], r[1]); w.y = cvt_pk_bf16(r[2], r[3]); w.z = cvt_pk_bf16(r[4], r[5]); w.w = cvt_pk_bf16(r[6], r[7]);
#if defined(ACT_NT) && ACT_NT
                __builtin_nontemporal_store(w, (u32x4*)rowp);
#else
                *(u32x4*)rowp = w;
#endif
            }
    }
};
typedef _Float16 f16x4 __attribute__((ext_vector_type(4)));
typedef _Float16 f16x8 __attribute__((ext_vector_type(8)));
template <bool F16> struct XIo;
template <> struct XIo<false> { typedef float T;
    static __device__ __forceinline__ void ld8(const float* p, f32x4& a, f32x4& b) { a = *(const f32x4*)p; b = *(const f32x4*)(p + 4); }
    static __device__ __forceinline__ void st8(float* p, const f32x4& a, const f32x4& b) { *(f32x4*)p = a; *(f32x4*)(p + 4) = b; } };
template <> struct XIo<true> { typedef _Float16 T;
    static __device__ __forceinline__ void ld8(const _Float16* p, f32x4& a, f32x4& b) { const f16x8 h = *(const f16x8*)p; a = (f32x4){(float)h[0], (float)h[1], (float)h[2], (float)h[3]}; b = (f32x4){(float)h[4], (float)h[5], (float)h[6], (float)h[7]}; }
    static __device__ __forceinline__ void st8(_Float16* p, const f32x4& a, const f32x4& b) { f16x8 h; h[0] = (_Float16)a[0]; h[1] = (_Float16)a[1]; h[2] = (_Float16)a[2]; h[3] = (_Float16)a[3]; h[4] = (_Float16)b[0]; h[5] = (_Float16)b[1]; h[6] = (_Float16)b[2]; h[7] = (_Float16)b[3]; *(f16x8*)p = h; } };
template <bool I16, bool SSM = false> struct EpiResidN {
    static constexpr bool PERM = true;
    const typename XIo<I16>::T* xin; _Float16* out; int ldc; const float* coef  ; int tiles_per_batch;
    const float* gs; const float* sh  ; bf16_t* hn; int ldh;
    float* xbuf  ; unsigned* cnt  ; PG8_LAS float* tbl  ; int nb = 0, nch = 0, sld = 0;
    __device__ __forceinline__ void operator()(f32x4 (&acc)[2][2][4][2], const Unit& u, int wr, int wc, int fr, int fq) const {
        asm volatile("" : "+v"(fr), "+v"(fq));
        const int wid = wr * 4 + wc, lane = fq * 16 + fr;
        const int row0 = u.pm * BM + wr * 64 + fr, col0 = u.pn * BM + wc * 32 + 8 * fq, bb = u.pm / tiles_per_batch;
        { const float* cf = coef + (size_t)bb * ldc + col0;
          f32x4 cv[2][2];
#pragma unroll
          for (int bj = 0; bj < 2; ++bj)
#pragma unroll
              for (int n = 0; n < 2; ++n) cv[bj][n] = *(const f32x4*)(cf + bj * HALF + 4 * n);
#pragma unroll
          for (int ai = 0; ai < 2; ++ai)
#pragma unroll
            for (int mh = 0; mh < 2; ++mh) { f32x4 xv[2][2][2];
#pragma unroll
              for (int m = 0; m < 2; ++m)
#pragma unroll
                  for (int bj = 0; bj < 2; ++bj) XIo<I16>::ld8(xin + (size_t)(row0 + ai * HALF + (2 * mh + m) * 16) * ldc + col0 + bj * HALF, xv[m][bj][0], xv[m][bj][1]);
#pragma unroll
              for (int m = 0; m < 2; ++m)
#pragma unroll
                  for (int bj = 0; bj < 2; ++bj) { const int mm = 2 * mh + m; acc[ai][bj][mm][0] = xv[m][bj][0] + cv[bj][0] * acc[ai][bj][mm][0]; acc[ai][bj][mm][1] = xv[m][bj][1] + cv[bj][1] * acc[ai][bj][mm][1];
                      XIo<true>::st8(out + (size_t)(row0 + ai * HALF + mm * 16) * ldc + col0 + bj * HALF, acc[ai][bj][mm][0], acc[ai][bj][mm][1]); }
              asm volatile("" ::: "memory"); } }
#pragma unroll
        for (int ai = 0; ai < 2; ++ai)
#pragma unroll
            for (int m = 0; m < 4; ++m) { float q = 0.f;
#pragma unroll
                for (int bj = 0; bj < 2; ++bj)
#pragma unroll
                    for (int n = 0; n < 2; ++n) { const f32x4 x = acc[ai][bj][m][n]; q += (x[0] * x[0] + x[1] * x[1]) + (x[2] * x[2] + x[3] * x[3]); }
                q += __shfl_xor(q, 16); q += __shfl_xor(q, 32);
                if (fq == 0) tbl[(ai * HALF + wr * 64 + m * 16 + fr) * 4 + wc] = q; }
        asm volatile("s_waitcnt lgkmcnt(0)" ::: "memory"); __builtin_amdgcn_s_barrier(); asm volatile("" ::: "memory");
        const int row = wid * 32 + (lane & 31);
        if (lane < 32) { const float t = (tbl[row * 4 + 0] + tbl[row * 4 + 1]) + (tbl[row * 4 + 2] + tbl[row * 4 + 3]);
            __hip_atomic_store((unsigned*)xbuf + ((size_t)(u.pm * BM + row) * 8 + u.pn), __builtin_bit_cast(unsigned, t), __ATOMIC_RELAXED, __HIP_MEMORY_SCOPE_AGENT); }
        asm volatile("s_waitcnt vmcnt(0)" ::: "memory");
        if (lane == 0) __hip_atomic_fetch_add(cnt + 64 * u.pm, 1u, __ATOMIC_RELAXED, __HIP_MEMORY_SCOPE_AGENT);
        if (wid == 0) { unsigned spins = 0u;
            while ((unsigned)__builtin_amdgcn_readfirstlane(__hip_atomic_load(cnt + 64 * u.pm, __ATOMIC_RELAXED, __HIP_MEMORY_SCOPE_AGENT)) < 64u) { __builtin_amdgcn_s_sleep(2); if (++spins > (1u << 22)) break; }
            __builtin_amdgcn_fence(__ATOMIC_ACQUIRE, "agent"); }
        asm volatile("s_waitcnt vmcnt(0) lgkmcnt(0)" ::: "memory"); __builtin_amdgcn_s_barrier(); asm volatile("" ::: "memory");
        if (lane < 32) { const unsigned* slot = (const unsigned*)xbuf + (size_t)(u.pm * BM + row) * 8; float q = 0.f;
#pragma unroll
            for (int t = 0; t < 8; ++t) q += __builtin_bit_cast(float, __hip_atomic_load(slot + t, __ATOMIC_RELAXED, __HIP_MEMORY_SCOPE_AGENT));
            tbl[1024 + row] = 1.0f / sqrtf(q * (1.0f / 2048.0f) + 1e-6f); }
        asm volatile("s_waitcnt lgkmcnt(0)" ::: "memory"); __builtin_amdgcn_s_barrier(); asm volatile("" ::: "memory");
        { const float* gp = gs + (size_t)bb * ldc + col0; const float* sp = sh + (size_t)bb * ldc + col0;
          f32x4 gv[2][2], sv[2][2];
#pragma unroll
          for (int bj = 0; bj < 2; ++bj)
#pragma unroll
              for (int n = 0; n < 2; ++n) { gv[bj][n] = *(const f32x4*)(gp + bj * HALF + 4 * n); sv[bj][n] = *(const f32x4*)(sp + bj * HALF + 4 * n); }
#pragma unroll
          for (int ai = 0; ai < 2; ++ai)
#pragma unroll
              for (int m = 0; m < 4; ++m) { const int rl = ai * HALF + wr * 64 + m * 16 + fr; const float rs = tbl[1024 + rl];
                  bf16_t* hp; size_t bjs = HALF;
                  if constexpr (SSM) { const int sq = (u.pm % tiles_per_batch) * BM + rl, ch = sq >> 4, tau = sq & 15;
                      hp = hn + ((size_t)((col0 >> 4) * nb + bb) * nch + ch) * sld + tau * 16 + (col0 & 15); bjs = (size_t)(HALF / 16) * nb * nch * sld; }
                  else hp = hn + (size_t)(u.pm * BM + rl) * ldh + col0;
#pragma unroll
                  for (int bj = 0; bj < 2; ++bj) { const f32x4 h0 = acc[ai][bj][m][0] * rs * gv[bj][0] + sv[bj][0], h1 = acc[ai][bj][m][1] * rs * gv[bj][1] + sv[bj][1];
                      u32x4 w; w.x = cvt_pk_bf16(h0[0], h0[1]); w.y = cvt_pk_bf16(h0[2], h0[3]); w.z = cvt_pk_bf16(h1[0], h1[1]); w.w = cvt_pk_bf16(h1[2], h1[3]);
                      *(u32x4*)(hp + bj * bjs) = w; } } }
    }
};
template <bool I16, bool O16> struct EpiResid {
    static constexpr bool PERM = true;
    const typename XIo<I16>::T* xin; typename XIo<O16>::T* out; int ldc; const float* coef  ; int tiles_per_batch;
    __device__ __forceinline__ void operator()(const f32x4 (&acc)[2][2][4][2], const Unit& u, int wr, int wc, int fr, int fq) const {
        asm volatile("" : "+v"(fr), "+v"(fq));
        const int row0 = u.pm * BM + wr * 64 + fr, col0 = u.pn * BM + wc * 32 + 8 * fq;
        const float* cf = coef + (size_t)(u.pm / tiles_per_batch) * ldc + col0;
        f32x4 cv[2][2];
#pragma unroll
        for (int bj = 0; bj < 2; ++bj)
#pragma unroll
            for (int n = 0; n < 2; ++n) cv[bj][n] = *(const f32x4*)(cf + bj * HALF + 4 * n);
#pragma unroll
        for (int ai = 0; ai < 2; ++ai) { f32x4 xv[4][2][2];
#pragma unroll
            for (int m = 0; m < 4; ++m)
#pragma unroll
                for (int bj = 0; bj < 2; ++bj) XIo<I16>::ld8(xin + (size_t)(row0 + ai * HALF + m * 16) * ldc + col0 + bj * HALF, xv[m][bj][0], xv[m][bj][1]);
#pragma unroll
            for (int m = 0; m < 4; ++m)
#pragma unroll
                for (int bj = 0; bj < 2; ++bj) XIo<O16>::st8(out + (size_t)(row0 + ai * HALF + m * 16) * ldc + col0 + bj * HALF, xv[m][bj][0] + cv[bj][0] * acc[ai][bj][m][0], xv[m][bj][1] + cv[bj][1] * acc[ai][bj][m][1]); }
    }
};
template <bool I16> struct EpiGLUN {
    static constexpr bool PERM = true;
    const typename XIo<I16>::T* xin; _Float16* out; int ldc; const float* coef; int tiles_per_batch;
    const float* gs; const float* sh; bf16_t* hn; int ldh; float* xbuf; unsigned* cnt; PG8_LAS float* tbl;
    __device__ __forceinline__ void operator()(f32x4 (&acc)[2][2][4][2], const Unit& u, int wr, int wc, int fr, int fq) const {
        asm volatile("" : "+v"(fr), "+v"(fq));
        const int wid = wr * 4 + wc, lane = fq * 16 + fr;
        const int row0 = u.pm * BM + wr * 64 + fr, col0 = u.pn * HALF + wc * 32 + 8 * fq, bb = u.pm / tiles_per_batch;
        { const float* cf = coef + (size_t)bb * ldc + col0;
          f32x4 cv[2];
#pragma unroll
          for (int n = 0; n < 2; ++n) cv[n] = *(const f32x4*)(cf + 4 * n);
#pragma unroll
          for (int ai = 0; ai < 2; ++ai) { f32x4 xv[4][2];
#pragma unroll
              for (int m = 0; m < 4; ++m) XIo<I16>::ld8(xin + (size_t)(row0 + ai * HALF + m * 16) * ldc + col0, xv[m][0], xv[m][1]);
#pragma unroll
              for (int m = 0; m < 4; ++m) {
#pragma unroll
                  for (int n = 0; n < 2; ++n) { const f32x4 v = acc[ai][0][m][n], g = acc[ai][1][m][n]; f32x4 o;
#pragma unroll
                      for (int j = 0; j < 4; ++j) o[j] = xv[m][n][j] + cv[n][j] * v[j] * sigmoidf_fast(g[j]);
                      acc[ai][0][m][n] = o; }
                  XIo<true>::st8(out + (size_t)(row0 + ai * HALF + m * 16) * ldc + col0, acc[ai][0][m][0], acc[ai][0][m][1]); }
              asm volatile("" ::: "memory"); } }
#pragma unroll
        for (int ai = 0; ai < 2; ++ai)
#pragma unroll
            for (int m = 0; m < 4; ++m) { float q = 0.f;
#pragma unroll
                for (int n = 0; n < 2; ++n) { const f32x4 x = acc[ai][0][m][n]; q += (x[0] * x[0] + x[1] * x[1]) + (x[2] * x[2] + x[3] * x[3]); }
                q += __shfl_xor(q, 16); q += __shfl_xor(q, 32);
                if (fq == 0) tbl[(ai * HALF + wr * 64 + m * 16 + fr) * 4 + wc] = q; }
        asm volatile("s_waitcnt lgkmcnt(0)" ::: "memory"); __builtin_amdgcn_s_barrier(); asm volatile("" ::: "memory");
        const int row = wid * 32 + (lane & 31);
        if (lane < 32) { const float t = (tbl[row * 4 + 0] + tbl[row * 4 + 1]) + (tbl[row * 4 + 2] + tbl[row * 4 + 3]);
            __hip_atomic_store((unsigned*)xbuf + ((size_t)(u.pm * BM + row) * 16 + u.pn), __builtin_bit_cast(unsigned, t), __ATOMIC_RELAXED, __HIP_MEMORY_SCOPE_AGENT); }
        asm volatile("s_waitcnt vmcnt(0)" ::: "memory");
        if (lane == 0) __hip_atomic_fetch_add(cnt + 64 * u.pm, 1u, __ATOMIC_RELAXED, __HIP_MEMORY_SCOPE_AGENT);
        if (wid == 0) { unsigned spins = 0u;
            while ((unsigned)__builtin_amdgcn_readfirstlane(__hip_atomic_load(cnt + 64 * u.pm, __ATOMIC_RELAXED, __HIP_MEMORY_SCOPE_AGENT)) < 128u) { __builtin_amdgcn_s_sleep(2); if (++spins > (1u << 22)) break; }
            __builtin_amdgcn_fence(__ATOMIC_ACQUIRE, "agent"); }
        asm volatile("s_waitcnt vmcnt(0) lgkmcnt(0)" ::: "memory"); __builtin_amdgcn_s_barrier(); asm volatile("" ::: "memory");
        if (lane < 32) { const unsigned* slot = (const unsigned*)xbuf + (size_t)(u.pm * BM + row) * 16; float q = 0.f;
#pragma unroll
            for (int t = 0; t < 16; ++t) q += __builtin_bit_cast(float, __hip_atomic_load(slot + t, __ATOMIC_RELAXED, __HIP_MEMORY_SCOPE_AGENT));
            tbl[1024 + row] = 1.0f / sqrtf(q * (1.0f / 2048.0f) + 1e-6f); }
        asm volatile("s_waitcnt lgkmcnt(0)" ::: "memory"); __builtin_amdgcn_s_barrier(); asm volatile("" ::: "memory");
        { const float* gp = gs + (size_t)bb * ldc + col0; const float* sp = sh + (size_t)bb * ldc + col0;
          f32x4 gv[2], sv[2];
#pragma unroll
          for (int n = 0; n < 2; ++n) { gv[n] = *(const f32x4*)(gp + 4 * n); sv[n] = *(const f32x4*)(sp + 4 * n); }
#pragma unroll
          for (int ai = 0; ai < 2; ++ai)
#pragma unroll
              for (int m = 0; m < 4; ++m) { const int rl = ai * HALF + wr * 64 + m * 16 + fr; const float rs = tbl[1024 + rl];
                  const f32x4 h0 = acc[ai][0][m][0] * rs * gv[0] + sv[0], h1 = acc[ai][0][m][1] * rs * gv[1] + sv[1];
                  u32x4 w; w.x = cvt_pk_bf16(h0[0], h0[1]); w.y = cvt_pk_bf16(h0[2], h0[3]); w.z = cvt_pk_bf16(h1[0], h1[1]); w.w = cvt_pk_bf16(h1[2], h1[3]);
                  *(u32x4*)(hn + (size_t)(u.pm * BM + rl) * ldh + col0) = w; } }
    }
};
template <bool I16, bool O16> struct EpiGLU {
    static constexpr bool PERM = true;
    const typename XIo<I16>::T* xin; typename XIo<O16>::T* out; int ldc; const float* coef; int tiles_per_batch;
    __device__ __forceinline__ void operator()(const f32x4 (&acc)[2][2][4][2], const Unit& u, int wr, int wc, int fr, int fq) const {
        asm volatile("" : "+v"(fr), "+v"(fq));
        const int row0 = u.pm * BM + wr * 64 + fr, col0 = u.pn * HALF + wc * 32 + 8 * fq;
        const float* cf = coef + (size_t)(u.pm / tiles_per_batch) * ldc + col0;
        f32x4 cv[2];
#pragma unroll
        for (int n = 0; n < 2; ++n) cv[n] = *(const f32x4*)(cf + 4 * n);
        f32x4 xv[2][4][2];
#pragma unroll
        for (int ai = 0; ai < 2; ++ai)
#pragma unroll
            for (int m = 0; m < 4; ++m) XIo<I16>::ld8(xin + (size_t)(row0 + ai * HALF + m * 16) * ldc + col0, xv[ai][m][0], xv[ai][m][1]);
#pragma unroll
        for (int ai = 0; ai < 2; ++ai)
#pragma unroll
            for (int m = 0; m < 4; ++m) { f32x4 o[2];
#pragma unroll
                for (int n = 0; n < 2; ++n) { const f32x4 v = acc[ai][0][m][n], g = acc[ai][1][m][n];
#pragma unroll
                    for (int j = 0; j < 4; ++j) o[n][j] = xv[ai][m][n][j] + cv[n][j] * v[j] * sigmoidf_fast(g[j]); }
                XIo<O16>::st8(out + (size_t)(row0 + ai * HALF + m * 16) * ldc + col0, o[0], o[1]); }
    }
};
struct EpiQKVN {
    static constexpr bool PERM = true;
    bf16_t* QH; bf16_t* KH; bf16_t* V; int seq; const float* gq; const float* gk; const float* rope; PG8_LAS float* red;
    __device__ __forceinline__ void operator()(const f32x4 (&acc)[2][2][4][2], const Unit& u, int wr, int wc, int fr, int fq) const {
        asm volatile("" : "+v"(fr), "+v"(fq));
        const int row0 = u.pm * BM + wr * 64 + fr, cin = wc * 32 + 8 * fq;
        if (u.pn >= 16) {
            const int h = u.pn - 16;
#pragma unroll
            for (int ai = 0; ai < 2; ++ai)
#pragma unroll
                for (int m = 0; m < 4; ++m) { const int row = row0 + ai * HALF + m * 16, b = row / seq, s = row - b * seq;
#pragma unroll
                    for (int bj = 0; bj < 2; ++bj) { const f32x4 v0 = acc[ai][bj][m][0], v1 = acc[ai][bj][m][1];
                        u32x4 w; w.x = cvt_pk_bf16(v0[0], v0[1]); w.y = cvt_pk_bf16(v0[2], v0[3]); w.z = cvt_pk_bf16(v1[0], v1[1]); w.w = cvt_pk_bf16(v1[2], v1[3]);
                        *(u32x4*)(V + ((size_t)(((b * 8 + h) * 2 + bj)) * seq + s) * 128 + cin) = w; } }
            return;
        }
        const int isk = u.pn >> 3, h = u.pn & 7;
#pragma unroll
        for (int ai = 0; ai < 2; ++ai)
#pragma unroll
            for (int m = 0; m < 4; ++m)
#pragma unroll
                for (int bj = 0; bj < 2; ++bj) { const f32x4 a = acc[ai][bj][m][0], b = acc[ai][bj][m][1];
                    float ss = (a[0] * a[0] + a[1] * a[1]) + (a[2] * a[2] + a[3] * a[3]) + (b[0] * b[0] + b[1] * b[1]) + (b[2] * b[2] + b[3] * b[3]);
                    ss += __shfl_xor(ss, 16); ss += __shfl_xor(ss, 32);
                    if (fq == 0) red[((ai * HALF + wr * 64 + m * 16 + fr) * 2 + bj) * 4 + wc] = ss; }
        asm volatile("s_waitcnt lgkmcnt(0)" ::: "memory"); __builtin_amdgcn_s_barrier(); asm volatile("" ::: "memory");
        const float* gg = (isk ? gk : gq) + cin;
        const f32x4 g0 = *(const f32x4*)gg, g1 = *(const f32x4*)(gg + 4);
        bf16_t* dstb = isk ? KH : QH;
#pragma unroll
        for (int ai = 0; ai < 2; ++ai)
#pragma unroll
            for (int m = 0; m < 4; ++m) { const int rl = ai * HALF + wr * 64 + m * 16 + fr, row = u.pm * BM + rl, b = row / seq, s = row - b * seq;
                f32x4 c0, c1, s0, s1;
                if (wc == 0) { const float* rp = rope + (size_t)row * 32 + 8 * (fq & 1); c0 = *(const f32x4*)rp; c1 = *(const f32x4*)(rp + 4); s0 = *(const f32x4*)(rp + 16); s1 = *(const f32x4*)(rp + 20); }
#pragma unroll
                for (int bj = 0; bj < 2; ++bj) { const f32x4 p = *(const PG8_LAS f32x4*)(red + (rl * 2 + bj) * 4);
                    const float rs = 1.0f / sqrtf(((p[0] + p[1]) + (p[2] + p[3])) * (1.0f / 128.0f) + 1e-6f);
                    f32x4 y0 = acc[ai][bj][m][0] * rs * g0, y1 = acc[ai][bj][m][1] * rs * g1;
                    if (wc == 0) {
                        f32x4 o0, o1;
#pragma unroll
                        for (int j = 0; j < 4; ++j) { o0[j] = __shfl_xor(y0[j], 32); o1[j] = __shfl_xor(y1[j], 32); }
                        if (fq < 2) { y0 = y0 * c0 - o0 * s0; y1 = y1 * c1 - o1 * s1; } else { y0 = y0 * c0 + o0 * s0; y1 = y1 * c1 + o1 * s1; }
                    }
                    u32x4 w; w.x = cvt_pk_bf16(y0[0], y0[1]); w.y = cvt_pk_bf16(y0[2], y0[3]); w.z = cvt_pk_bf16(y1[0], y1[1]); w.w = cvt_pk_bf16(y1[2], y1[3]);
                    *(u32x4*)(dstb + ((size_t)((b * 8 + h) * 2 + bj) * seq + s) * 128 + cin) = w; } }
    }
};
struct EpiState {
    static constexpr bool PERM = false;
    float* S;
    __device__ __forceinline__ void operator()(const f32x4 (&acc)[2][2][4][2], const Unit& u, int wr, int wc, int fr, int fq) const {
        asm volatile("" : "+v"(fr), "+v"(fq));
        const int row0 = u.pm * BM + wr * 64 + fr, col0 = wc * 32 + 4 * fq;
#pragma unroll
        for (int ai = 0; ai < 2; ++ai)
#pragma unroll
            for (int m = 0; m < 4; ++m) { float* rowp = S + (size_t)(row0 + ai * HALF + m * 16) * 128 + col0;
#pragma unroll
                for (int n = 0; n < 2; ++n) *(f32x4*)(rowp + n * 16) = acc[ai][0][m][n]; }
    }
};
struct EpiSsmY {
    static constexpr bool PERM = true;
    bf16_t* Z; int seq, ldz;
    __device__ __forceinline__ void operator()(const f32x4 (&acc)[2][2][4][2], const Unit& u, int wr, int wc, int fr, int fq) const {
        asm volatile("" : "+v"(fr), "+v"(fq));
        const int g = u.pm >> 2, b = u.pm & 3;
        char* zu = (char*)Z + ((size_t)b * seq * ldz + 16 * g) * 2;
        const unsigned loff = (unsigned)((16 * (wr * 64 + fr) + 2 * wc + (fq >> 1)) * ldz + 8 * (fq & 1)) * 2u;
#pragma unroll
        for (int ai = 0; ai < 2; ++ai)
#pragma unroll
            for (int m = 0; m < 4; ++m) {
#pragma unroll
                for (int bj = 0; bj < 2; ++bj) {
                    float r[8];
#pragma unroll
                    for (int n = 0; n < 2; ++n)
#pragma unroll
                        for (int j = 0; j < 4; ++j) { const float y = acc[ai][bj][m][n][j]; r[n * 4 + j] = y * sigmoidf_fast(1.5957691216057308f * y * (1.0f + 0.044715f * y * y)); }
                    u32x4 w; w.x = cvt_pk_bf16(r[0], r[1]); w.y = cvt_pk_bf16(r[2], r[3]); w.z = cvt_pk_bf16(r[4], r[5]); w.w = cvt_pk_bf16(r[6], r[7]);
                    *(u32x4*)(zu + (loff + (unsigned)(((ai * HALF + m * 16) * 16 + 8 * bj) * ldz) * 2u)) = w; } }
    }
};

struct EpiNull {
    static constexpr bool PERM = false;
    __device__ __forceinline__ void operator()(const f32x4 (&acc)[2][2][4][2], const Unit& u, int wr, int wc, int fr, int fq) const {
#pragma unroll
        for (int ai = 0; ai < 2; ++ai)
#pragma unroll
            for (int bj = 0; bj < 2; ++bj)
#pragma unroll
                for (int m = 0; m < 4; ++m)
#pragma unroll
                    for (int n = 0; n < 2; ++n) asm volatile("" :: "v"(acc[ai][bj][m][n]));
    }
};
template <class Epi>
__device__ __forceinline__ void gemm_phase(PG8_LAS unsigned char* lds, const Gemm g, const StaticOrder& S, const Epi& E) {
    const int tid = ptid(), wid = __builtin_amdgcn_readfirstlane(tid >> 6), lane = tid & 63, wr = wid >> 2, wc = wid & 3, fr = lane & 15, fq = lane >> 4;
    const int K = g.K, nt = K / BK;
    unsigned voffA[2], voffB[2];
#pragma unroll
    for (int i = 0; i < 2; ++i) { int R, C; stage_rc(tid * 16 + i * 8192, R, C); const int Rb = Epi::PERM ? ((R & ~31) + perm32(R & 31)) : R;
        voffA[i] = (unsigned)(R * g.lda + C) * 2u; voffB[i] = (unsigned)(Rb * g.ldb + C) * 2u; }
    const long kstep = g.krev ? -(long)(BK * 2) : (long)(BK * 2);
    const long kbase = g.krev ? (long)(nt - 1) * (BK * 2) : 0;
    const size_t hstepA = (size_t)HALF * g.lda * 2, hstepB = (size_t)HALF * g.ldb * 2;
    const size_t tstepA = 2 * hstepA, tstepB = 2 * hstepB;
    const unsigned ldsw = (unsigned)wid * 1024u;
    const int aoff = lds_byte(wr * 64 + fr, fq * 8), boff = lds_byte(wc * 32 + fr, fq * 8);
#define PG8_SA(b, h) (((b) * 2 + (h)) * HTB)
#define PG8_SB(b, h) ((4 + (b) * 2 + (h)) * HTB)
#define PG8_STAGE(bufoff, gbase, voff) do { _Pragma("unroll") for (int _i = 0; _i < 2; ++_i) \
        __builtin_amdgcn_global_load_lds((const unsigned*)((const char*)(gbase) + (voff)[_i]), (PG8_LAS unsigned*)(lds + (bufoff) + ldsw + _i * 8192), 16, 0, 0); } while (0)
#define PG8_LDA(dst, b, h) do { _Pragma("unroll") for (int m = 0; m < 4; ++m) _Pragma("unroll") for (int k = 0; k < 2; ++k) dst[m][k] = *(const PG8_LAS bf16x8*)(lds + PG8_SA(b, h) + aoff + m * 2048 + k * 1024); } while (0)
#define PG8_LDB(dst, b, h) do { _Pragma("unroll") for (int n = 0; n < 2; ++n) _Pragma("unroll") for (int k = 0; k < 2; ++k) dst[n][k] = *(const PG8_LAS bf16x8*)(lds + PG8_SB(b, h) + boff + n * 2048 + k * 1024); } while (0)
#ifndef PG8_PRIO
#define PG8_PRIO 1
#endif
#if PG8_PRIO == 2
#define PG8_MMA(ai, bj, At, Bt) do { _Pragma("unroll") for (int k = 0; k < 2; ++k) { __builtin_amdgcn_s_setprio(1); _Pragma("unroll") for (int m = 0; m < 4; ++m) _Pragma("unroll") for (int n = 0; n < 2; ++n) \
        acc[ai][bj][m][n] = __builtin_amdgcn_mfma_f32_16x16x32_bf16(Bt[n][k], At[m][k], acc[ai][bj][m][n], 0, 0, 0); __builtin_amdgcn_s_setprio(0); __builtin_amdgcn_sched_barrier(0); } } while (0)
#else
#define PG8_MMA(ai, bj, At, Bt) do { if (PG8_PRIO) __builtin_amdgcn_s_setprio(1); _Pragma("unroll") for (int m = 0; m < 4; ++m) _Pragma("unroll") for (int n = 0; n < 2; ++n) _Pragma("unroll") for (int k = 0; k < 2; ++k) \
        acc[ai][bj][m][n] = __builtin_amdgcn_mfma_f32_16x16x32_bf16(Bt[n][k], At[m][k], acc[ai][bj][m][n], 0, 0, 0); if (PG8_PRIO) __builtin_amdgcn_s_setprio(0); } while (0)
#endif
#define PG8_MMA2(ai, At, B0_, B1_) do { __builtin_amdgcn_s_setprio(1); _Pragma("unroll") for (int m = 0; m < 4; ++m) _Pragma("unroll") for (int n = 0; n < 2; ++n) _Pragma("unroll") for (int k = 0; k < 2; ++k) \
        acc[ai][0][m][n] = __builtin_amdgcn_mfma_f32_16x16x32_bf16(B0_[n][k], At[m][k], acc[ai][0][m][n], 0, 0, 0); \
        _Pragma("unroll") for (int m = 0; m < 4; ++m) _Pragma("unroll") for (int n = 0; n < 2; ++n) _Pragma("unroll") for (int k = 0; k < 2; ++k) \
        acc[ai][1][m][n] = __builtin_amdgcn_mfma_f32_16x16x32_bf16(B1_[n][k], At[m][k], acc[ai][1][m][n], 0, 0, 0); __builtin_amdgcn_s_setprio(0); } while (0)
#define PG8_WAIT_V(n) asm volatile("s_waitcnt vmcnt(" #n ")" ::: "memory")
#define PG8_WAIT_L(n) asm volatile("s_waitcnt lgkmcnt(" #n ")" ::: "memory")
#define PG8_BAR __builtin_amdgcn_s_barrier()
#define PG8_SCHED __builtin_amdgcn_sched_barrier(0)
#define PG8_BTILE(u) (g.grp ? (u).pm / g.grp : (u).pn)
    Unit cur, nxt; int ui = 0;
    if (!S.next(0, cur)) return;
    f32x4 acc[2][2][4][2];
#pragma unroll
    for (int a = 0; a < 2; ++a)
#pragma unroll
        for (int b = 0; b < 2; ++b)
#pragma unroll
            for (int m = 0; m < 4; ++m)
#pragma unroll
                for (int n = 0; n < 2; ++n) acc[a][b][m][n] = (f32x4){0.f, 0.f, 0.f, 0.f};
    bf16x8 At[4][2], B0[2][2], B1[2][2];
    const char* cA = (const char*)g.A + (size_t)cur.pm * tstepA + kbase; const char* cB = (const char*)g.Bt + (size_t)PG8_BTILE(cur) * tstepB + kbase;
#if PG8_USE_SP2
    PG8_STAGE(PG8_SB(0, 0), cB, voffB); PG8_STAGE(PG8_SB(0, 1), cB + hstepB, voffB); PG8_STAGE(PG8_SA(0, 0), cA, voffA); PG8_STAGE(PG8_SA(0, 1), cA + hstepA, voffA);
    if (wr == 1) PG8_BAR;
    PG8_WAIT_V(2); PG8_BAR;
    PG8_STAGE(PG8_SB(1, 0), cB + kstep, voffB); PG8_STAGE(PG8_SA(1, 0), cA + kstep, voffA); PG8_STAGE(PG8_SB(1, 1), cB + hstepB + kstep, voffB);
    PG8_WAIT_V(6); PG8_BAR;
#else
    PG8_STAGE(PG8_SB(0, 0), cB, voffB); PG8_STAGE(PG8_SA(0, 0), cA, voffA); PG8_STAGE(PG8_SB(0, 1), cB + hstepB, voffB); PG8_STAGE(PG8_SA(0, 1), cA + hstepA, voffA);
    if (wr == 1) PG8_BAR;
    PG8_WAIT_V(4); PG8_BAR;
    PG8_STAGE(PG8_SB(1, 0), cB + kstep, voffB); PG8_STAGE(PG8_SA(1, 0), cA + kstep, voffA); PG8_STAGE(PG8_SB(1, 1), cB + hstepB + kstep, voffB);
    PG8_WAIT_V(6); PG8_BAR;
#endif
    for (;;) {
        const bool has_next = S.next(ui + 1, nxt);
        const char* nA = has_next ? (const char*)g.A + (size_t)nxt.pm * tstepA + kbase : cA; const char* nB = has_next ? (const char*)g.Bt + (size_t)PG8_BTILE(nxt) * tstepB + kbase : cB;
#pragma nounroll
        for (int t = 0; t < nt; t += 2) {
            const bool last = (t == nt - 2);
            const char* a1 = cA + (long)(t + 1) * kstep;
            const char* a2 = last ? nA : cA + (long)(t + 2) * kstep; const char* b2 = last ? nB : cB + (long)(t + 2) * kstep;
            const char* a3 = a2 + kstep; const char* b3 = b2 + kstep;
#if PG8_USE_SP2
            PG8_LDB(B0, 0, 0); PG8_LDB(B1, 0, 1); PG8_SCHED; PG8_LDA(At, 0, 0); PG8_STAGE(PG8_SA(1, 1), a1 + hstepA, voffA);
            PG8_WAIT_V(8); PG8_WAIT_L(0); PG8_BAR; PG8_MMA(0, 0, At, B0); PG8_MMA(0, 1, At, B1); PG8_BAR; PG8_SCHED;
            PG8_LDA(At, 0, 1); PG8_STAGE(PG8_SB(0, 0), b2, voffB); PG8_STAGE(PG8_SB(0, 1), b2 + hstepB, voffB); PG8_STAGE(PG8_SA(0, 0), a2, voffA);
            PG8_WAIT_V(8); PG8_WAIT_L(0); PG8_BAR; PG8_MMA(1, 0, At, B0); PG8_MMA(1, 1, At, B1); PG8_BAR; PG8_SCHED;
            PG8_LDB(B0, 1, 0); PG8_LDB(B1, 1, 1); PG8_SCHED; PG8_LDA(At, 1, 0); PG8_STAGE(PG8_SA(0, 1), a2 + hstepA, voffA);
            PG8_WAIT_V(8); PG8_WAIT_L(0); PG8_BAR; PG8_MMA(0, 0, At, B0); PG8_MMA(0, 1, At, B1); PG8_BAR; PG8_SCHED;
            PG8_LDA(At, 1, 1); PG8_STAGE(PG8_SB(1, 0), b3, voffB); PG8_STAGE(PG8_SB(1, 1), b3 + hstepB, voffB); PG8_STAGE(PG8_SA(1, 0), a3, voffA);
            PG8_WAIT_V(8); PG8_WAIT_L(0); PG8_BAR; PG8_MMA(1, 0, At, B0); PG8_MMA(1, 1, At, B1); PG8_BAR; PG8_SCHED;
#else
            PG8_LDB(B0, 0, 0); PG8_SCHED; PG8_LDA(At, 0, 0); PG8_STAGE(PG8_SA(1, 1), a1 + hstepA, voffA);
            PG8_WAIT_L(8); PG8_BAR; PG8_WAIT_L(0); PG8_MMA(0, 0, At, B0); PG8_BAR; PG8_SCHED;
            PG8_LDB(B1, 0, 1); PG8_STAGE(PG8_SB(0, 0), b2, voffB);
            PG8_BAR; PG8_WAIT_L(0); PG8_MMA(0, 1, At, B1); PG8_BAR;
            PG8_LDA(At, 0, 1); PG8_STAGE(PG8_SA(0, 0), a2, voffA);
            PG8_BAR; PG8_WAIT_L(0); PG8_MMA(1, 0, At, B0); PG8_BAR; PG8_SCHED;
            PG8_STAGE(PG8_SB(0, 1), b2 + hstepB, voffB);
            PG8_WAIT_V(6); PG8_BAR; PG8_MMA(1, 1, At, B1); PG8_BAR;
            PG8_LDB(B0, 1, 0); PG8_SCHED; PG8_LDA(At, 1, 0); PG8_STAGE(PG8_SA(0, 1), a2 + hstepA, voffA);
            PG8_WAIT_L(8); PG8_BAR; PG8_WAIT_L(0); PG8_MMA(0, 0, At, B0); PG8_BAR; PG8_SCHED;
            PG8_LDB(B1, 1, 1); PG8_STAGE(PG8_SB(1, 0), b3, voffB);
            PG8_BAR; PG8_WAIT_L(0); PG8_MMA(0, 1, At, B1); PG8_BAR;
            PG8_LDA(At, 1, 1); PG8_STAGE(PG8_SA(1, 0), a3, voffA);
            PG8_BAR; PG8_WAIT_L(0); PG8_MMA(1, 0, At, B0); PG8_BAR; PG8_SCHED;
            PG8_STAGE(PG8_SB(1, 1), b3 + hstepB, voffB);
            PG8_WAIT_V(6); PG8_BAR; PG8_MMA(1, 1, At, B1); PG8_BAR;
#endif
        }
        if (wr == 0) PG8_BAR;
        E(acc, cur, wr, wc, fr, fq);
        if (!has_next) break;
#pragma unroll
        for (int a = 0; a < 2; ++a)
#pragma unroll
            for (int b = 0; b < 2; ++b)
#pragma unroll
                for (int m = 0; m < 4; ++m)
#pragma unroll
                    for (int n = 0; n < 2; ++n) acc[a][b][m][n] = (f32x4){0.f, 0.f, 0.f, 0.f};
        cur = nxt; cA = nA; cB = nB; ++ui;
        if (wr == 1) PG8_BAR;
    }
    PG8_WAIT_V(0);
    PG8_BAR;
#undef PG8_SA
#undef PG8_SB
#undef PG8_STAGE
#undef PG8_LDA
#undef PG8_LDB
#undef PG8_MMA
#undef PG8_MMA2
#undef PG8_WAIT_V
#undef PG8_WAIT_L
#undef PG8_BAR
#undef PG8_SCHED
#undef PG8_BTILE
}
}
namespace att {
using TIN = __hip_bfloat16; using TOUT = __hip_bfloat16;
constexpr int B = 4, H = 32, HKV = 32, SQ = 4096, SKV = 4096, D = 128;
constexpr int QOFF = 0;
constexpr int WINDOW = SKV;
constexpr float THR = 8.f;
constexpr bool WSKIP = false;
constexpr float SCALE = 0.08838834764831845f;
constexpr int NW = 8, QBLK = 32, KVBLK = 64, QB = NW * QBLK;
constexpr int SHM_V = KVBLK * D * 2, SHM_K = KVBLK * D * 2;
constexpr int LDS_BYTES = 2 * SHM_V + 2 * SHM_K + NW * 64 * 4;
static_assert(D == 128 && SQ % QB == 0 && SKV % KVBLK == 0 && H % HKV == 0 && QOFF >= 0 && QOFF + SQ <= SKV && WINDOW >= 1, "geometry");

using bf16 = __hip_bfloat16;
typedef short bf16x8 __attribute__((ext_vector_type(8)));
typedef short s16x4 __attribute__((ext_vector_type(4)));
typedef float f32x16 __attribute__((ext_vector_type(16)));
typedef float f32x4 __attribute__((ext_vector_type(4)));
typedef unsigned u32x4 __attribute__((ext_vector_type(4)));
template <class A, class Bt> struct same_t { static constexpr bool v = false; };
template <class A> struct same_t<A, A> { static constexpr bool v = true; };

#define KSWZ(row, colB) ((row) * 256 + ((colB) ^ (((row) & 7) << 4)))
#define SBAR() __builtin_amdgcn_sched_barrier(0)
__device__ __forceinline__ int v_st(int k, int c) { const int kk = (k & ~0xC) | ((k & 4) << 1) | ((k & 8) >> 1); return ((kk >> 3) * 4 + (c >> 5)) * 512 + ((kk & 7) * 32 + (c & 31)) * 2; }
__device__ __forceinline__ int v_rd_base(int lane) { return ((lane & 3) << 3) | (((lane >> 2) & 3) << 6) | (((lane >> 4) & 1) << 5) | (((lane >> 5) & 1) << 8); }
constexpr int v_rd_off(int d0, int ks, int half) { return d0 * 512 + ks * 4096 + half * 2048; }
__device__ __forceinline__ int crow(int r, int hi) { return (r & 3) + 8 * (r >> 2) + 4 * hi; }
__device__ __forceinline__ unsigned cvtpk(float lo, float hi) {
    unsigned r; asm volatile("v_cvt_pk_bf16_f32 %0, %1, %2" : "=v"(r) : "v"(lo), "v"(hi)); return r;
}
__device__ __forceinline__ bf16x8 pack8(f32x4 a, f32x4 b) {
    u32x4 w = {cvtpk(a[0], a[1]), cvtpk(a[2], a[3]), cvtpk(b[0], b[1]), cvtpk(b[2], b[3])};
    return *reinterpret_cast<bf16x8*>(&w);
}
template <class T> __device__ __forceinline__ bf16x8 load8(const T* p) {
    if constexpr (same_t<T, float>::v) { return pack8(*(const f32x4*)p, *(const f32x4*)(p + 4)); }
    else { return *reinterpret_cast<const bf16x8*>(p); }
}
__device__ __forceinline__ void mask_tile(f32x16& p0, f32x16& p1, int dq, unsigned W) {
    const float NEG = -__builtin_inff();
#pragma unroll
    for (int r = 0; r < 16; ++r) {
        const int c = (r & 3) + 8 * (r >> 2);
        if ((unsigned)(dq - c) >= W) p0[r] = NEG;
        if ((unsigned)(dq - c - 32) >= W) p1[r] = NEG;
    }
}
__device__ __forceinline__ void partialSM(f32x16& p0, f32x16& p1, float& m_reg, float& mn, float& alpha) {
    float pmax = p0[0]; for (int r = 1; r < 16; ++r) pmax = fmaxf(pmax, p0[r]); for (int r = 0; r < 16; ++r) pmax = fmaxf(pmax, p1[r]);
    { auto rr = __builtin_amdgcn_permlane32_swap(__float_as_uint(pmax), __float_as_uint(pmax), false, false);
      pmax = fmaxf(__uint_as_float(rr[0]), __uint_as_float(rr[1])); }
    constexpr float C2 = 1.4426950408889634f * SCALE;
    if (__builtin_expect(__all((pmax - m_reg) * SCALE <= THR), 1)) { mn = m_reg; alpha = 1.f; }
    else { mn = fmaxf(m_reg, pmax); alpha = __builtin_amdgcn_exp2f((m_reg - mn) * C2); m_reg = mn; }
    const float mnL = -mn * C2;
    for (int r = 0; r < 16; ++r) p0[r] = fmaf(p0[r], C2, mnL); for (int r = 0; r < 16; ++r) p1[r] = fmaf(p1[r], C2, mnL);
    for (int r = 0; r < 16; ++r) p0[r] = __builtin_amdgcn_exp2f(p0[r]);
}
__device__ __forceinline__ void finishSM(f32x16& p0, f32x16& p1, float alpha, float& l_reg, bf16x8& pa0, bf16x8& pa1, bf16x8& pa2, bf16x8& pa3) {
    for (int r = 0; r < 16; ++r) p1[r] = __builtin_amdgcn_exp2f(p1[r]);
    float ps = 0; for (int r = 0; r < 16; ++r) ps += p0[r]; for (int r = 0; r < 16; ++r) ps += p1[r];
    { auto rr = __builtin_amdgcn_permlane32_swap(__float_as_uint(ps), __float_as_uint(ps), false, false);
      ps = __uint_as_float(rr[0]) + __uint_as_float(rr[1]); }
    l_reg = l_reg * alpha + ps;
#define PK4(P, B_, OUT) do { unsigned a0 = cvtpk(P[B_+0], P[B_+1]), a1 = cvtpk(P[B_+2], P[B_+3]);                          \
        unsigned b0 = cvtpk(P[B_+4], P[B_+5]), b1 = cvtpk(P[B_+6], P[B_+7]);                                             \
        auto r0 = __builtin_amdgcn_permlane32_swap(a0, b0, false, false); auto r1 = __builtin_amdgcn_permlane32_swap(a1, b1, false, false); \
        u32x4 w = {r0[0], r1[0], r0[1], r1[1]}; OUT = *reinterpret_cast<bf16x8*>(&w); } while (0)
    PK4(p0, 0, pa0); PK4(p0, 8, pa1); PK4(p1, 0, pa2); PK4(p1, 8, pa3);
#undef PK4
}
template <int KB, bool SK>
__device__ __forceinline__ void qkt(f32x16& p0, f32x16& p1, const char* K_lds, int r32, int hi, const bf16x8* qr, bool act) {
    if (SK && !act) { const float NEG = -__builtin_inff();
#pragma unroll
        for (int r = 0; r < 16; ++r) { p0[r] = NEG; p1[r] = NEG; } return; }
    p0 = f32x16{}; p1 = f32x16{};
    const char* kb[4];
#pragma unroll
    for (int dd = 0; dd < 4; ++dd) kb[dd] = K_lds + KB * SHM_K + KSWZ(r32, (dd * 16 + hi * 8) * 2);
#pragma unroll
    for (int d0 = 0; d0 < 8; ++d0) { const char* a = kb[d0 & 3] + (d0 >> 2) * 128;
        bf16x8 b0 = *reinterpret_cast<const bf16x8*>(a);
        bf16x8 b1 = *reinterpret_cast<const bf16x8*>(a + 32 * 256);
        p0 = __builtin_amdgcn_mfma_f32_32x32x16_bf16(b0, qr[d0], p0, 0, 0, 0);
        p1 = __builtin_amdgcn_mfma_f32_32x32x16_bf16(b1, qr[d0], p1, 0, 0, 0); }
}
template <int VB, bool SK>
__device__ __forceinline__ void pv_tile(f32x16* o, int vb0, bf16x8 pa0, bf16x8 pa1, bf16x8 pa2, bf16x8 pa3, bool act) {
    if (SK && !act) return;
#define TRRD(dst, off) asm volatile("ds_read_b64_tr_b16 %0, %1 offset:%2" : "=&v"(dst) : "v"(vb0), "i"(off) : "memory")
#define PV_D0(d0) do { s16x4 l0, l1, l2, l3, h0, h1, h2, h3; constexpr int b_ = VB * SHM_V + v_rd_off(d0, 0, 0);     \
        TRRD(l0, b_); TRRD(h0, b_ + 2048); TRRD(l1, b_ + 4096); TRRD(h1, b_ + 6144); TRRD(l2, b_ + 8192); TRRD(h2, b_ + 10240); TRRD(l3, b_ + 12288); TRRD(h3, b_ + 14336); \
        asm volatile("s_waitcnt lgkmcnt(0)" ::: "memory"); SBAR();                 \
        o[d0] = __builtin_amdgcn_mfma_f32_32x32x16_bf16(pa0, (bf16x8){l0[0], l0[1], l0[2], l0[3], h0[0], h0[1], h0[2], h0[3]}, o[d0], 0, 0, 0);   \
        o[d0] = __builtin_amdgcn_mfma_f32_32x32x16_bf16(pa1, (bf16x8){l1[0], l1[1], l1[2], l1[3], h1[0], h1[1], h1[2], h1[3]}, o[d0], 0, 0, 0);   \
        o[d0] = __builtin_amdgcn_mfma_f32_32x32x16_bf16(pa2, (bf16x8){l2[0], l2[1], l2[2], l2[3], h2[0], h2[1], h2[2], h2[3]}, o[d0], 0, 0, 0);   \
        o[d0] = __builtin_amdgcn_mfma_f32_32x32x16_bf16(pa3, (bf16x8){l3[0], l3[1], l3[2], l3[3], h3[0], h3[1], h3[2], h3[3]}, o[d0], 0, 0, 0); } while (0)
    PV_D0(0); PV_D0(1); PV_D0(2); PV_D0(3);
#undef PV_D0
#undef TRRD
}

template <class TIn, class TOut> struct BlockRef { const TIn* Q; const TIn* K; const TIn* V; TOut* O; int P0; };
template <class TIn> struct Seam {
    bf16x8 qr[8];
    bf16x8 st_v0, st_v1, st_k0, st_k1; f32x4 sf0, sf1, sf2, sf3;
    f32x4 tq[16];
};
__device__ __forceinline__ int swa_jlo(int P0, int W) { const int lowk = P0 - W + 1; return lowk > 0 ? lowk / KVBLK : 0; }
#define ROW(p, k0, rr) ((p) + (size_t)((k0) + (rr)) * D + sc)
#define VMW() asm volatile("s_waitcnt vmcnt(0)" ::: "memory")
#define VMWN(n) asm volatile("s_waitcnt vmcnt(%0)" :: "i"(n) : "memory")
#define SLOAD_H(Kp, Vp, k0) do { S.st_v0 = load8<TIn>(ROW(Vp, k0, sr)); S.st_v1 = load8<TIn>(ROW(Vp, k0, 32 + sr));              \
                         S.st_k0 = load8<TIn>(ROW(Kp, k0, sr)); S.st_k1 = load8<TIn>(ROW(Kp, k0, 32 + sr)); } while (0)
#define SWRITE_HK(bf) do { *(bf16x8*)(K_lds + (bf) * SHM_K + kws) = S.st_k0; *(bf16x8*)(K_lds + (bf) * SHM_K + kws + 32 * 256) = S.st_k1; } while (0)
#define SWRITE_HV(bf) do { *(bf16x8*)(V_lds + (bf) * SHM_V + vst0) = S.st_v0; *(bf16x8*)(V_lds + (bf) * SHM_V + vst1) = S.st_v1; } while (0)
#define SWRITE_H(bf) do { SWRITE_HV(bf); SWRITE_HK(bf); } while (0)
#define SLOAD_F(p, k0) do { S.sf0 = *(const f32x4*)ROW(p, k0, sr); S.sf1 = *(const f32x4*)(ROW(p, k0, sr) + 4);                \
                            S.sf2 = *(const f32x4*)ROW(p, k0, 32 + sr); S.sf3 = *(const f32x4*)(ROW(p, k0, 32 + sr) + 4); } while (0)
#define SWRITE_KF(bf) do { *(bf16x8*)(K_lds + (bf) * SHM_K + kws) = pack8(S.sf0, S.sf1); *(bf16x8*)(K_lds + (bf) * SHM_K + kws + 32 * 256) = pack8(S.sf2, S.sf3); } while (0)
#define SWRITE_VF(bf) do { *(bf16x8*)(V_lds + (bf) * SHM_V + vst0) = pack8(S.sf0, S.sf1); *(bf16x8*)(V_lds + (bf) * SHM_V + vst1) = pack8(S.sf2, S.sf3); } while (0)
template <class TIn, class TOut>
__device__ __forceinline__ void causal_swa_prime(const BlockRef<TIn, TOut>& cur, int W, char* lds, Seam<TIn>& S) {
    constexpr bool F32 = same_t<TIn, float>::v;
    const int tid = ptid(), wid = __builtin_amdgcn_readfirstlane(tid >> 6), lane = tid & 63, r32 = lane & 31, hi = lane >> 5;
    const int sr = tid >> 4, sc = (tid & 15) * 8, kws = KSWZ(sr, sc * 2); char* K_lds = lds + 2 * SHM_V;
    const int kb0 = swa_jlo(cur.P0, W) * KVBLK;
    for (int d0 = 0; d0 < 8; ++d0) S.qr[d0] = load8<TIn>(cur.Q + (size_t)(wid * QBLK + r32) * D + d0 * 16 + hi * 8);
    if constexpr (F32) { SLOAD_F((const float*)cur.K, kb0); VMW(); SWRITE_KF(0); SBAR(); SLOAD_F((const float*)cur.V, kb0); }
    else { SLOAD_H(cur.K, cur.V, kb0); VMW(); SWRITE_HK(0); }
    __syncthreads();
}
template <class TIn, class TOut>
__device__ __forceinline__ void causal_swa_block(const BlockRef<TIn, TOut>& cur, const BlockRef<TIn, TOut>& nxt, int skv, int W, char* lds, Seam<TIn>& S) {
    constexpr bool F32 = same_t<TIn, float>::v;
    const int tid = ptid(), wid = __builtin_amdgcn_readfirstlane(tid >> 6), lane = tid & 63, r32 = lane & 31, hi = lane >> 5;
    const int j_lo = swa_jlo(cur.P0, W);
    int j_hi = (cur.P0 + QB - 1) / KVBLK + 1; if (j_hi > skv / KVBLK) j_hi = skv / KVBLK;
    const int NT = j_hi - j_lo;
    const int kbn = swa_jlo(nxt.P0, W) * KVBLK;
    const int qlo = cur.P0 + wid * QBLK, qm = qlo + r32 - 4 * hi;
    char* V_lds = lds; char* K_lds = lds + 2 * SHM_V;
    float* ws = (float*)(lds + 2 * SHM_V + 2 * SHM_K) + wid * 64; float* li_l = ws, * al_l = ws + 32;
    float m_reg = -1e30f, l_reg = 0; f32x16 o[4] = {};
    const int sr = tid >> 4, sc = (tid & 15) * 8, vst0 = v_st(sr, sc), vst1 = v_st(32 + sr, sc), kws = KSWZ(sr, sc * 2);
    const int vb0 = (int)(uintptr_t)V_lds + v_rd_base(lane);
    const TIn* Kh = cur.K; const TIn* Vh = cur.V;
#define RESC(a) do { if (__any((a) < 1.f)) { if (hi == 0) al_l[r32] = (a); asm volatile("s_waitcnt lgkmcnt(0)" ::: "memory");              \
                     for (int d_ = 0; d_ < 4; ++d_) for (int r = 0; r < 16; ++r) o[d_][r] *= al_l[crow(r, hi)]; } } while (0)
#define KBASE(t) ((j_lo + (t)) * KVBLK)
#define ACT(t) (KBASE(t) <= qlo + QBLK - 1 && KBASE(t) + KVBLK - 1 >= qlo - W + 1)
#define MASKT(P0_, P1_, t) do { const int kb_ = KBASE(t); if ((!SK || ACT(t)) && (kb_ + KVBLK - 1 > qlo || kb_ <= qlo + QBLK - 1 - W)) mask_tile(P0_, P1_, qm - kb_, (unsigned)W); } while (0)
    constexpr int NQL = F32 ? 16 : 8;
    constexpr bool SK = WSKIP && !F32;
#define SEAM_K0() do { VMWN(NQL); if constexpr (F32) { SWRITE_KF(0); SBAR(); SLOAD_F((const float*)nxt.V, kbn); } else { SWRITE_HK(0); } SBAR(); } while (0)
    f32x16 pA0, pA1, pB0, pB1; float mnA, mnB, alA, alB; bf16x8 pa0, pa1, pa2, pa3;
    if constexpr (F32) { VMW(); SWRITE_VF(0); SBAR(); } else { SWRITE_HV(0); SBAR(); }
    if (NT > 1) { if constexpr (F32) SLOAD_F((const float*)Kh, KBASE(1)); else SLOAD_H(Kh, Vh, KBASE(1)); }
    SBAR(); qkt<0, SK>(pA0, pA1, K_lds, r32, hi, S.qr, ACT(0));
    if constexpr (F32) { if (NT > 1) { VMW(); SWRITE_KF(1); SBAR(); SLOAD_F((const float*)Vh, KBASE(1)); } }
    MASKT(pA0, pA1, 0); partialSM(pA0, pA1, m_reg, mnA, alA);
    if (NT > 1) { VMW(); if constexpr (F32) { SWRITE_VF(1); SBAR(); if (NT > 2) SLOAD_F((const float*)Kh, KBASE(2)); } else SWRITE_H(1); }
    __syncthreads();
#define HALF_STEP(PX0, PX1, mnX, alX, PY0, PY1, alY, t, KB, VB, SB) do {                                                      \
        SBAR(); qkt<KB, SK>(PX0, PX1, K_lds, r32, hi, S.qr, ACT(t));                                             \
        finishSM(PY0, PY1, alY, l_reg, pa0, pa1, pa2, pa3); SBAR();                                                           \
        if ((t) + 1 < NT) { if constexpr (F32) { VMW(); SWRITE_KF(SB); SBAR(); SLOAD_F((const float*)Vh, KBASE((t) + 1)); }  \
                            else { SLOAD_H(Kh, Vh, KBASE((t) + 1)); } SBAR(); }                                               \
        pv_tile<VB, SK>(o, vb0, pa0, pa1, pa2, pa3, ACT((t) - 1)); MASKT(PX0, PX1, (t)); partialSM(PX0, PX1, m_reg, mnX, alX);                                        \
        __syncthreads();                                                                                                      \
        if ((t) + 1 < NT) { VMW(); if constexpr (F32) { SWRITE_VF(SB); SBAR(); if ((t) + 2 < NT) SLOAD_F((const float*)Kh, KBASE((t) + 2)); } \
                            else { SWRITE_H(SB); } }                                                                          \
        RESC(alX); __syncthreads(); } while (0)
    for (int t = 1; t + 1 < NT; t += 2) {
        HALF_STEP(pB0, pB1, mnB, alB, pA0, pA1, alA, t, 1, 0, 0);
        HALF_STEP(pA0, pA1, mnA, alA, pB0, pB1, alB, t + 1, 0, 1, 1);
    }
    const bool even = (NT & 1) == 0;
    if (even) { SBAR(); qkt<1, SK>(pB0, pB1, K_lds, r32, hi, S.qr, ACT(NT - 1)); SBAR(); }
#define QROW(e) (nxt.Q + (size_t)(wid * QBLK + r32) * D + ((e) >> 1) * 16 + hi * 8 + ((e) & 1) * 4)
    if constexpr (F32) { SLOAD_F((const float*)nxt.K, kbn); SBAR();
#pragma unroll
        for (int e = 0; e < 8; ++e) S.tq[e] = *(const f32x4*)QROW(e); }
    else { SLOAD_H(nxt.K, nxt.V, kbn); SBAR();
#pragma unroll
        for (int d0 = 0; d0 < 8; ++d0) S.qr[d0] = load8<TIn>(nxt.Q + (size_t)(wid * QBLK + r32) * D + d0 * 16 + hi * 8); }
    SBAR();
    finishSM(pA0, pA1, alA, l_reg, pa0, pa1, pa2, pa3); SBAR();
    if constexpr (F32) {
#pragma unroll
        for (int e = 8; e < 16; ++e) S.tq[e] = *(const f32x4*)QROW(e); SBAR(); }
#undef QROW
    pv_tile<0, SK>(o, vb0, pa0, pa1, pa2, pa3, ACT(even ? NT - 2 : NT - 1));
    if (even) { MASKT(pB0, pB1, NT - 1); partialSM(pB0, pB1, m_reg, mnB, alB); __syncthreads(); RESC(alB);
        finishSM(pB0, pB1, alB, l_reg, pa0, pa1, pa2, pa3); SBAR(); pv_tile<1, SK>(o, vb0, pa0, pa1, pa2, pa3, ACT(NT - 1)); }
    SBAR(); SEAM_K0();
    if (hi == 0) li_l[r32] = l_reg; asm volatile("s_waitcnt lgkmcnt(0)" ::: "memory");
    float rli[16];
#pragma unroll
    for (int r = 0; r < 16; ++r) rli[r] = __builtin_amdgcn_rcpf(li_l[crow(r, hi)]);
    TOut* Ow = cur.O + (size_t)(wid * QBLK) * D;
#pragma unroll
    for (int r = 0; r < 16; ++r) { const int orow = crow(r, hi);
#pragma unroll
        for (int d0 = 0; d0 < 4; ++d0) { const float v = o[d0][r] * rli[r];
            if constexpr (same_t<TOut, float>::v) { Ow[(size_t)orow * D + d0 * 32 + r32] = v; }
            else { const float vn = __shfl_xor(v, 1);
                   if ((r32 & 1) == 0) *(unsigned*)(Ow + (size_t)orow * D + d0 * 32 + r32) = cvtpk(v, vn); } } }
    if constexpr (F32) {
#pragma unroll
        for (int d0 = 0; d0 < 8; ++d0) S.qr[d0] = pack8(S.tq[2 * d0], S.tq[2 * d0 + 1]); }
    __syncthreads();
#undef RESC
#undef KBASE
#undef ACT
#undef MASKT
#undef SEAM_K0
#undef HALF_STEP
}
#undef ROW
#undef VMW
#undef VMWN
#undef SLOAD_H
#undef SWRITE_HK
#undef SWRITE_HV
#undef SWRITE_H
#undef SLOAD_F
#undef SWRITE_KF
#undef SWRITE_VF
}
namespace att {
#define SKA_LAS __attribute__((address_space(3)))
constexpr int SKA_STATS = 148480;
struct SkaRef { const bf16* Q; const bf16* K; const bf16* V0; const bf16* V1; bf16* O; int P0; int pm; };
constexpr float SKA_C2 = 1.4426950408889634f * SCALE;
__device__ __forceinline__ void ska_sm_a(f32x16& s, float& m_reg, float& mn, float& alpha) {
    float pmax = s[0];
#pragma unroll
    for (int r = 1; r < 16; ++r) pmax = fmaxf(pmax, s[r]);
    { auto rr = __builtin_amdgcn_permlane32_swap(__float_as_uint(pmax), __float_as_uint(pmax), false, false);
      pmax = fmaxf(__uint_as_float(rr[0]), __uint_as_float(rr[1])); }
    if (__builtin_expect(__all((pmax - m_reg) * SCALE <= THR), 1)) { mn = m_reg; alpha = 1.f; }
    else { mn = fmaxf(m_reg, pmax); alpha = __builtin_amdgcn_exp2f((m_reg - mn) * SKA_C2); m_reg = mn; }
    const float mnL = -mn * SKA_C2;
#pragma unroll
    for (int r = 0; r < 16; ++r) s[r] = fmaf(s[r], SKA_C2, mnL);
#pragma unroll
    for (int r = 0; r < 8; ++r) s[r] = __builtin_amdgcn_exp2f(s[r]);
}
__device__ __forceinline__ void ska_sm_b(f32x16& s, float alpha, float& l_reg, bf16x8& pa0, bf16x8& pa1) {
#pragma unroll
    for (int r = 8; r < 16; ++r) s[r] = __builtin_amdgcn_exp2f(s[r]);
    float ps = 0;
#pragma unroll
    for (int r = 0; r < 16; ++r) ps += s[r];
    { auto rr = __builtin_amdgcn_permlane32_swap(__float_as_uint(ps), __float_as_uint(ps), false, false);
      ps = __uint_as_float(rr[0]) + __uint_as_float(rr[1]); }
    l_reg = l_reg * alpha + ps;
#define PK4(P, B_, OUT) do { unsigned a0 = cvtpk(P[B_+0], P[B_+1]), a1 = cvtpk(P[B_+2], P[B_+3]);                          \
        unsigned b0 = cvtpk(P[B_+4], P[B_+5]), b1 = cvtpk(P[B_+6], P[B_+7]);                                             \
        auto r0 = __builtin_amdgcn_permlane32_swap(a0, b0, false, false); auto r1 = __builtin_amdgcn_permlane32_swap(a1, b1, false, false); \
        u32x4 w = {r0[0], r1[0], r0[1], r1[1]}; OUT = *reinterpret_cast<bf16x8*>(&w); } while (0)
    PK4(s, 0, pa0); PK4(s, 8, pa1);
#undef PK4
}
__device__ __forceinline__ void ska_mask(f32x16& s, int dq) {
    const float NEG = -__builtin_inff();
#pragma unroll
    for (int r = 0; r < 16; ++r) { const int c = (r & 3) + 8 * (r >> 2); if (dq - c < 0) s[r] = NEG; }
}
__device__ __forceinline__ void ska_pv(f32x16* o, int vb, bf16x8 pa0, bf16x8 pa1) {
#define TRRD(dst, off) asm volatile("ds_read_b64_tr_b16 %0, %1 offset:%2" : "=&v"(dst) : "v"(vb), "i"(off) : "memory")
#define SKA_RD(F, blk) do { constexpr int b_ = ((blk) >> 2) * 16384 + ((blk) & 3) * 512; TRRD(F[0], b_); TRRD(F[1], b_ + 2048); TRRD(F[2], b_ + 4096); TRRD(F[3], b_ + 6144); } while (0)
#define SKA_MM(F, blk) do { \
        o[blk] = __builtin_amdgcn_mfma_f32_32x32x16_bf16(pa0, (bf16x8){F[0][0], F[0][1], F[0][2], F[0][3], F[1][0], F[1][1], F[1][2], F[1][3]}, o[blk], 0, 0, 0); \
        o[blk] = __builtin_amdgcn_mfma_f32_32x32x16_bf16(pa1, (bf16x8){F[2][0], F[2][1], F[2][2], F[2][3], F[3][0], F[3][1], F[3][2], F[3][3]}, o[blk], 0, 0, 0); } while (0)
#define SKA_W4() do { asm volatile("s_waitcnt lgkmcnt(4)" ::: "memory"); SBAR(); } while (0)
#define SKA_W0() do { asm volatile("s_waitcnt lgkmcnt(0)" ::: "memory"); SBAR(); } while (0)
    s16x4 fa[4], fb[4];
    SBAR();
    SKA_RD(fa, 0);
    SKA_RD(fb, 1); SKA_W4(); SKA_MM(fa, 0); SBAR();
    SKA_RD(fa, 2); SKA_W4(); SKA_MM(fb, 1); SBAR();
    SKA_RD(fb, 3); SKA_W4(); SKA_MM(fa, 2); SBAR();
    SKA_RD(fa, 4); SKA_W4(); SKA_MM(fb, 3); SBAR();
    SKA_RD(fb, 5); SKA_W4(); SKA_MM(fa, 4); SBAR();
    SKA_RD(fa, 6); SKA_W4(); SKA_MM(fb, 5); SBAR();
    SKA_RD(fb, 7); SKA_W4(); SKA_MM(fa, 6); SBAR();
    SKA_W0(); SKA_MM(fb, 7); SBAR();
#undef SKA_W0
#undef SKA_W4
#undef SKA_MM
#undef SKA_RD
#undef TRRD
}
template <int KH>
__device__ __forceinline__ void ska_merge(f32x16* o, const SkaRef& R, char* lds, int wid, int lane, int rg, const float* fr) {
    constexpr int KEEP = KH * 4, SEND = (1 - KH) * 4;
    const int r32 = lane & 31, hi = lane >> 5;
    f32x4* xs = reinterpret_cast<f32x4*>(lds + wid * 16384) + lane;
#pragma unroll
    for (int d = 0; d < 4; ++d)
#pragma unroll
        for (int q = 0; q < 4; ++q) { f32x4 v = {o[SEND + d][4 * q] * fr[4 * q], o[SEND + d][4 * q + 1] * fr[4 * q + 1], o[SEND + d][4 * q + 2] * fr[4 * q + 2], o[SEND + d][4 * q + 3] * fr[4 * q + 3]};
            xs[(d * 4 + q) * 64] = v; }
    __syncthreads();
    const f32x4* xr = reinterpret_cast<const f32x4*>(lds + (wid ^ 4) * 16384) + lane;
    bf16* Ow = R.O + (size_t)(rg * 32) * 256 + KEEP * 32 + r32;
#pragma unroll
    for (int d = 0; d < 4; ++d)
#pragma unroll
        for (int q = 0; q < 4; ++q) { const f32x4 p = xr[(d * 4 + q) * 64];
#pragma unroll
            for (int j = 0; j < 4; ++j) { const int r = 4 * q + j; const float v = o[KEEP + d][r] * fr[r] + p[j];
                const float vn = __shfl_xor(v, 1);
                if ((r32 & 1) == 0) *(unsigned*)(Ow + (size_t)crow(r, hi) * 256 + d * 32) = cvtpk(v, vn); } }
}
__device__ __forceinline__ void ska_block(const SkaRef& R, char* lds, SKA_LAS unsigned char* ldsl) {
    const int tid = ptid(), wid = __builtin_amdgcn_readfirstlane(tid >> 6), lane = tid & 63, r32 = lane & 31, hi = lane >> 5;
    const int rg = wid & 3, kh = wid >> 2, pm = R.pm;
    const int NT = (R.P0 + 127) / KVBLK + 1;
    const int qlo = R.P0 + rg * 32, qm = qlo + r32 - 4 * hi - 32 * kh;
    const char* gK; const char* gV0; const char* gV1;
    { const int row = tid >> 4, cp = tid & 15; gK = (const char*)R.K + row * 256 + ((cp ^ (row & 7)) << 4);
      const int sub = tid >> 5, kk = (sub >> 2) * 8 + ((tid >> 2) & 7), k = (kk & ~0xC) | ((kk & 4) << 1) | ((kk & 8) >> 1), c = (sub & 3) * 32 + (tid & 3) * 8;
      gV0 = (const char*)R.V0 + k * 256 + c * 2; gV1 = (const char*)R.V1 + k * 256 + c * 2; }
    const unsigned ldsw = (unsigned)wid * 1024u;
#define SKA_G(g, l) __builtin_amdgcn_global_load_lds((const unsigned*)(g), (SKA_LAS unsigned*)(ldsl + (l)), 16, 0, 0)
#define SKA_DMAK(T_, KS_) do { if (pm == 3) break; const size_t go_ = pm == 1 ? 0 : (size_t)(T_) * (KVBLK * 256); const unsigned kd_ = (unsigned)(KS_) * 16384u + ldsw; SKA_G(gK + go_, kd_); SKA_G(gK + go_ + 8192, kd_ + 8192); } while (0)
#define SKA_DMAV(T_, VS_) do { if (pm == 3) break; const size_t go_ = pm == 1 ? 0 : (size_t)(T_) * (KVBLK * 256); const unsigned vd_ = 49152u + (unsigned)(VS_) * 32768u + ldsw; \
        SKA_G(gV0 + go_, vd_); SKA_G(gV0 + go_ + 8192, vd_ + 8192); SKA_G(gV1 + go_, vd_ + 16384); SKA_G(gV1 + go_ + 8192, vd_ + 24576); } while (0)
    char* Kl = lds; float* st = (float*)(lds + SKA_STATS) + wid * 128;
    int kofs[4];
#pragma unroll
    for (int dd = 0; dd < 4; ++dd) kofs[dd] = KSWZ(r32 + 32 * kh, (dd * 16 + hi * 8) * 2);
    const int vb0 = (int)(uintptr_t)(lds + 49152) + v_rd_base(lane) + kh * 8192;
#define SKA_QK(S_, KS_) do { S_ = f32x16{}; const char* kp_ = Kl + (KS_) * 16384; _Pragma("unroll") for (int d0 = 0; d0 < 8; ++d0) { \
        const bf16x8 b_ = *reinterpret_cast<const bf16x8*>(kp_ + kofs[d0 & 3] + (d0 >> 2) * 128); S_ = __builtin_amdgcn_mfma_f32_32x32x16_bf16(b_, qr[d0], S_, 0, 0, 0); } } while (0)
#define SKA_MASK(S_, T_) do { const int kb_ = (T_) * KVBLK; if (kb_ + 32 * kh + 31 > qlo) ska_mask(S_, qm - kb_); } while (0)
#define SKA_RESC(a) do { if (__any((a) < 1.f)) { if (hi == 0) st[r32] = (a); asm volatile("s_waitcnt lgkmcnt(0)" ::: "memory");              \
        _Pragma("unroll") for (int d_ = 0; d_ < 8; ++d_) _Pragma("unroll") for (int r = 0; r < 16; ++r) o[d_][r] *= st[crow(r, hi)]; } } while (0)
    SKA_DMAK(0, 0); SKA_DMAV(0, 0); if (NT > 1) SKA_DMAK(1, 1);
    bf16x8 qr[8];
#pragma unroll
    for (int d0 = 0; d0 < 8; ++d0) qr[d0] = *reinterpret_cast<const bf16x8*>(R.Q + (size_t)(rg * 32 + r32) * D + d0 * 16 + hi * 8);
    float m_reg = -1e30f, l_reg = 0; f32x16 o[8] = {};
    f32x16 sA, sB; float mnA, mnB, alA, alB; bf16x8 pa0, pa1;
    asm volatile("s_waitcnt vmcnt(0)" ::: "memory"); __syncthreads();
    if (NT > 2) SKA_DMAK(2, 2);
    if (NT > 1) SKA_DMAV(1, 1);
    SBAR(); SKA_QK(sA, 0); SKA_MASK(sA, 0); ska_sm_a(sA, m_reg, mnA, alA);
    __syncthreads();
    int kr = 1, kw = 0, vr = 0, vw = 2;
#define SKA_STEP(SX, mnX, alX, SY, alY, T_) do { const int t_ = (T_);                                                          \
        if (t_ + 2 < NT) SKA_DMAK(t_ + 2, kw);                                                                                 \
        if (t_ + 1 < NT) SKA_DMAV(t_ + 1, vw);                                                                                 \
        SBAR(); SKA_QK(SX, kr);                                                                                                \
        if (pm != 4) ska_sm_b(SY, alY, l_reg, pa0, pa1); else { pa0 = (bf16x8){(short)SY[0], 1, 2, 3, 4, 5, 6, 7}; pa1 = pa0; } SBAR();    \
        if (pm != 5) ska_pv(o, vb0 + vr * 32768, pa0, pa1); SKA_MASK(SX, t_); if (pm != 4) ska_sm_a(SX, m_reg, mnX, alX); else alX = 1.f;   \
        SKA_RESC(alX);                                                                                                         \
        if (t_ + 2 < NT) asm volatile("s_waitcnt vmcnt(6)" ::: "memory"); else if (t_ + 1 < NT) asm volatile("s_waitcnt vmcnt(4)" ::: "memory"); else asm volatile("s_waitcnt vmcnt(0)" ::: "memory"); \
        if (pm != 2) __syncthreads();                                                                                          \
        kr = kr == 2 ? 0 : kr + 1; kw = kw == 2 ? 0 : kw + 1; vr = vr == 2 ? 0 : vr + 1; vw = vw == 2 ? 0 : vw + 1; } while (0)
#pragma nounroll
    for (int t = 1; t < NT; ++t) { SKA_STEP(sB, mnB, alB, sA, alA, t); sA = sB; alA = alB; }
    ska_sm_b(sA, alA, l_reg, pa0, pa1); SBAR(); ska_pv(o, vb0 + vr * 32768, pa0, pa1);
    if (hi == 0) { st[32 + r32] = m_reg; st[64 + r32] = l_reg; }
    __syncthreads();
    { const float* sp = (const float*)(lds + SKA_STATS) + (wid ^ 4) * 128;
      const float mp = sp[32 + r32], lp = sp[64 + r32], m = fmaxf(m_reg, mp);
      const float wsf = __builtin_amdgcn_exp2f((m_reg - m) * SKA_C2), wpf = __builtin_amdgcn_exp2f((mp - m) * SKA_C2);
      const float f = wsf * __builtin_amdgcn_rcpf(l_reg * wsf + lp * wpf);
      if (hi == 0) st[r32] = f; asm volatile("s_waitcnt lgkmcnt(0)" ::: "memory"); }
    float fr[16];
#pragma unroll
    for (int r = 0; r < 16; ++r) fr[r] = st[crow(r, hi)];
    if (kh == 0) ska_merge<0>(o, R, lds, wid, lane, rg, fr); else ska_merge<1>(o, R, lds, wid, lane, rg, fr);
    __syncthreads();
#undef SKA_STEP
#undef SKA_RESC
#undef SKA_MASK
#undef SKA_QK
#undef SKA_DMAK
#undef SKA_DMAV
#undef SKA_G
}
}
namespace att {
constexpr int WVA_STATS = 148480;
__device__ __forceinline__ void wva_pv(f32x16* o, int vb, bf16x8 pa0, bf16x8 pa1, bf16x8 pa2, bf16x8 pa3) {
#define TRRD(dst, off) asm volatile("ds_read_b64_tr_b16 %0, %1 offset:%2" : "=&v"(dst) : "v"(vb), "i"(off) : "memory")
#define WVA_RD(F, j) do { constexpr int b_ = (((j) >> 1) >> 2) * 16384 + (((j) >> 1) & 3) * 512 + ((j) & 1) * 8192; TRRD(F[0], b_); TRRD(F[1], b_ + 2048); TRRD(F[2], b_ + 4096); TRRD(F[3], b_ + 6144); } while (0)
#define WVA_MM(F, j, PA, PB) do { \
        o[(j) >> 1] = __builtin_amdgcn_mfma_f32_32x32x16_bf16(PA, (bf16x8){F[0][0], F[0][1], F[0][2], F[0][3], F[1][0], F[1][1], F[1][2], F[1][3]}, o[(j) >> 1], 0, 0, 0); \
        o[(j) >> 1] = __builtin_amdgcn_mfma_f32_32x32x16_bf16(PB, (bf16x8){F[2][0], F[2][1], F[2][2], F[2][3], F[3][0], F[3][1], F[3][2], F[3][3]}, o[(j) >> 1], 0, 0, 0); } while (0)
#define WVA_W4() do { asm volatile("s_waitcnt lgkmcnt(4)" ::: "memory"); SBAR(); } while (0)
#define WVA_W0() do { asm volatile("s_waitcnt lgkmcnt(0)" ::: "memory"); SBAR(); } while (0)
#define WVA_2(j) do { WVA_RD(fb, (j) + 1); WVA_W4(); WVA_MM(fa, (j), pa0, pa1); SBAR(); WVA_RD(fa, (j) + 2); WVA_W4(); WVA_MM(fb, (j) + 1, pa2, pa3); SBAR(); } while (0)
    s16x4 fa[4], fb[4];
    SBAR();
    WVA_RD(fa, 0);
    WVA_2(0); WVA_2(2); WVA_2(4); WVA_2(6); WVA_2(8); WVA_2(10); WVA_2(12);
    WVA_RD(fb, 15); WVA_W4(); WVA_MM(fa, 14, pa0, pa1); SBAR(); WVA_W0(); WVA_MM(fb, 15, pa2, pa3); SBAR();
#undef WVA_2
#undef WVA_W0
#undef WVA_W4
#undef WVA_MM
#undef WVA_RD
#undef TRRD
}
__device__ __forceinline__ void wva_qk(f32x16& p0, f32x16& p1, const int* ka, const bf16x8* qr) {
#define KRD(dst, i) asm volatile("ds_read_b128 %0, %1 offset:%2" : "=&v"(dst) : "v"(ka[((i) >> 1) & 3]), "i"((((i) >> 1) >> 2) * 128 + ((i) & 1) * 8192) : "memory")
#define KW(n) do { asm volatile("s_waitcnt lgkmcnt(" #n ")" ::: "memory"); SBAR(); } while (0)
#define KMM(f, i) do { if ((i) & 1) p1 = __builtin_amdgcn_mfma_f32_32x32x16_bf16(f, qr[(i) >> 1], p1, 0, 0, 0); else p0 = __builtin_amdgcn_mfma_f32_32x32x16_bf16(f, qr[(i) >> 1], p0, 0, 0, 0); SBAR(); } while (0)
    bf16x8 f0, f1, f2, f3;
    p0 = f32x16{}; p1 = f32x16{};
    SBAR(); KRD(f0, 0); KRD(f1, 1); KRD(f2, 2);
    KRD(f3, 3); KW(3); KMM(f0, 0);   KRD(f0, 4); KW(3); KMM(f1, 1);   KRD(f1, 5); KW(3); KMM(f2, 2);   KRD(f2, 6); KW(3); KMM(f3, 3);
    KRD(f3, 7); KW(3); KMM(f0, 4);   KRD(f0, 8); KW(3); KMM(f1, 5);   KRD(f1, 9); KW(3); KMM(f2, 6);   KRD(f2, 10); KW(3); KMM(f3, 7);
    KRD(f3, 11); KW(3); KMM(f0, 8);  KRD(f0, 12); KW(3); KMM(f1, 9);  KRD(f1, 13); KW(3); KMM(f2, 10); KRD(f2, 14); KW(3); KMM(f3, 11);
    KRD(f3, 15); KW(3); KMM(f0, 12); KW(2); KMM(f1, 13); KW(1); KMM(f2, 14); KW(0); KMM(f3, 15);
#undef KMM
#undef KW
#undef KRD
}
__device__ __forceinline__ void wva_block(const SkaRef& R, char* lds, SKA_LAS unsigned char* ldsl, int cmode, float lam, const float* sg, bf16* HAo, int hap) {
    const int tid = ptid(), wid = __builtin_amdgcn_readfirstlane(tid >> 6), lane = tid & 63, r32 = lane & 31, hi = lane >> 5;
    const int NT = (R.P0 + 255) / KVBLK + 1;
    const int qlo = R.P0 + wid * 32, qm = qlo + r32 - 4 * hi;
    const char* gK; const char* gV0; const char* gV1;
    { const int row = tid >> 4, cp = tid & 15; gK = (const char*)R.K + row * 256 + ((cp ^ (row & 7)) << 4);
      const int sub = tid >> 5, kk = (sub >> 2) * 8 + ((tid >> 2) & 7), k = (kk & ~0xC) | ((kk & 4) << 1) | ((kk & 8) >> 1), c = (sub & 3) * 32 + (tid & 3) * 8;
      gV0 = (const char*)R.V0 + k * 256 + c * 2; gV1 = (const char*)R.V1 + k * 256 + c * 2; }
    const unsigned ldsw = (unsigned)wid * 1024u;
#define WVA_G(g, l) __builtin_amdgcn_global_load_lds((const unsigned*)(g), (SKA_LAS unsigned*)(ldsl + (l)), 16, 0, 0)
#define WVA_DMA(T_, S_) do { const size_t go_ = (size_t)(T_) * (KVBLK * 256); const unsigned kd_ = (unsigned)(S_) * 16384u + ldsw, vd_ = 49152u + (unsigned)(S_) * 32768u + ldsw; \
        WVA_G(gK + go_, kd_); WVA_G(gK + go_ + 8192, kd_ + 8192); WVA_G(gV0 + go_, vd_); WVA_G(gV0 + go_ + 8192, vd_ + 8192); WVA_G(gV1 + go_, vd_ + 16384); WVA_G(gV1 + go_ + 8192, vd_ + 24576); } while (0)
    float* st = (float*)(lds + WVA_STATS) + wid * 64;
    const int vb0 = (int)(uintptr_t)(lds + 49152) + v_rd_base(lane);
    int kb0[4];
#pragma unroll
    for (int dd = 0; dd < 4; ++dd) kb0[dd] = (int)(uintptr_t)lds + KSWZ(r32, (dd * 16 + hi * 8) * 2);
#define WVA_RESC(a) do { if (__any((a) < 1.f)) { if (hi == 0) st[r32] = (a); asm volatile("s_waitcnt lgkmcnt(0)" ::: "memory");              \
        _Pragma("unroll") for (int d_ = 0; d_ < 8; ++d_) _Pragma("unroll") for (int r = 0; r < 16; ++r) o[d_][r] *= st[crow(r, hi)]; } } while (0)
    WVA_DMA(0, 0); if (NT > 1) WVA_DMA(1, 1);
    bf16x8 qr[8];
#pragma unroll
    for (int d0 = 0; d0 < 8; ++d0) qr[d0] = *reinterpret_cast<const bf16x8*>(R.Q + (size_t)(wid * 32 + r32) * D + d0 * 16 + hi * 8);
    float m_reg = -1e30f, l_reg = 0; f32x16 o[8] = {};
    asm volatile("s_waitcnt vmcnt(0)" ::: "memory"); __syncthreads();
    int sr = 0, sw = 2;
#pragma nounroll
    for (int t = 0; t < NT; ++t) {
        if (t + 2 < NT) WVA_DMA(t + 2, sw);
        if (t * KVBLK <= qlo + 31) {
        f32x16 p0, p1; float mn, al; bf16x8 pa0, pa1, pa2, pa3;
        { int ka[4];
#pragma unroll
          for (int dd = 0; dd < 4; ++dd) ka[dd] = kb0[dd] + sr * 16384;
          wva_qk(p0, p1, ka, qr); }
        { const int kb = t * KVBLK; if (kb + KVBLK - 1 > qlo) mask_tile(p0, p1, qm - kb, (unsigned)SKV); }
        partialSM(p0, p1, m_reg, mn, al); finishSM(p0, p1, al, l_reg, pa0, pa1, pa2, pa3);
        WVA_RESC(al); SBAR();
        wva_pv(o, vb0 + sr * 32768, pa0, pa1, pa2, pa3);
        }
        if (t + 2 < NT) asm volatile("s_waitcnt vmcnt(6)" ::: "memory"); else asm volatile("s_waitcnt vmcnt(0)" ::: "memory");
        __syncthreads();
        sr = sr == 2 ? 0 : sr + 1; sw = sw == 2 ? 0 : sw + 1;
    }
    if (hi == 0) st[32 + r32] = l_reg; asm volatile("s_waitcnt lgkmcnt(0)" ::: "memory");
    float rli[16];
#pragma unroll
    for (int r = 0; r < 16; ++r) rli[r] = __builtin_amdgcn_rcpf(st[32 + crow(r, hi)]);
    if (cmode == 0) {
        bf16* Ow = R.O + (size_t)(wid * 32) * 256 + r32;
#pragma unroll
        for (int r = 0; r < 16; ++r) { const int orow = crow(r, hi);
#pragma unroll
            for (int d0 = 0; d0 < 8; ++d0) { const float v = o[d0][r] * rli[r]; const float vn = __shfl_xor(v, 1);
                if ((r32 & 1) == 0) *(unsigned*)(Ow + (size_t)orow * 256 + d0 * 32) = cvtpk(v, vn); } }
    } else {
        char* wl = lds + wid * 16384; const bf16* O0w = R.O + (size_t)(wid * 32) * 256;
#pragma unroll
        for (int hb = 0; hb < 2; ++hb) { u32x4 tq[8];
#pragma unroll
            for (int j = 0; j < 8; ++j) tq[j] = *reinterpret_cast<const u32x4*>(O0w + (size_t)(2 * (hb * 8 + j) + hi) * 256 + r32 * 8);
#pragma unroll
            for (int j = 0; j < 8; ++j) *reinterpret_cast<u32x4*>(wl + (2 * (hb * 8 + j) + hi) * 512 + r32 * 16) = tq[j]; }
        float sg8[8];
#pragma unroll
        for (int d0 = 0; d0 < 8; ++d0) sg8[d0] = sg[d0 * 32 + r32] * 0.8f;
        asm volatile("s_waitcnt lgkmcnt(0)" ::: "memory");
        bf16* Hw = HAo + (size_t)(wid * 32) * hap + r32;
#pragma unroll
        for (int r = 0; r < 16; ++r) { const int orow = crow(r, hi); float df[8]; float ss = 0.f;
#pragma unroll
            for (int d0 = 0; d0 < 8; ++d0) { const unsigned short h0 = *reinterpret_cast<const unsigned short*>(wl + orow * 512 + (d0 * 32 + r32) * 2);
                df[d0] = __builtin_bit_cast(float, (unsigned)h0 << 16) - lam * (o[d0][r] * rli[r]); ss += df[d0] * df[d0]; }
            ss += __shfl_xor(ss, 1); ss += __shfl_xor(ss, 2); ss += __shfl_xor(ss, 4); ss += __shfl_xor(ss, 8); ss += __shfl_xor(ss, 16);
            const float rs = 1.0f / sqrtf(ss * (1.0f / 256.f) + 1e-6f);
#pragma unroll
            for (int d0 = 0; d0 < 8; ++d0) { const float v = df[d0] * rs * sg8[d0]; const float vn = __shfl_xor(v, 1);
                if ((r32 & 1) == 0) *(unsigned*)(Hw + (size_t)orow * hap + d0 * 32) = cvtpk(v, vn); } }
        __syncthreads();
    }
#undef WVA_RESC
#undef WVA_DMA
#undef WVA_G
}
}
namespace att {
__device__ __forceinline__ void wvh_qk(f32x16& s, const int* ka, const bf16x8* qr) {
#define KRD(dst, i) asm volatile("ds_read_b128 %0, %1 offset:%2" : "=&v"(dst) : "v"(ka[(i) & 3]), "i"(((i) >> 2) * 128) : "memory")
#define KW(n) do { asm volatile("s_waitcnt lgkmcnt(" #n ")" ::: "memory"); SBAR(); } while (0)
#define KMM(f, i) do { s = __builtin_amdgcn_mfma_f32_32x32x16_bf16(f, qr[i], s, 0, 0, 0); SBAR(); } while (0)
    bf16x8 f0, f1, f2;
    s = f32x16{};
    SBAR(); KRD(f0, 0); KRD(f1, 1);
    KRD(f2, 2); KW(2); KMM(f0, 0);   KRD(f0, 3); KW(2); KMM(f1, 1);   KRD(f1, 4); KW(2); KMM(f2, 2);
    KRD(f2, 5); KW(2); KMM(f0, 3);   KRD(f0, 6); KW(2); KMM(f1, 4);   KRD(f1, 7); KW(2); KMM(f2, 5);
    KW(1); KMM(f0, 6); KW(0); KMM(f1, 7);
#undef KMM
#undef KW
#undef KRD
}
__device__ __forceinline__ void wvh_block(const SkaRef& R, char* lds, SKA_LAS unsigned char* ldsl, int cmode, float lam, const float* sg, bf16* HAo, int hap) {
    const int tid = ptid(), wid = __builtin_amdgcn_readfirstlane(tid >> 6), lane = tid & 63, r32 = lane & 31, hi = lane >> 5;
    const int NT = (R.P0 + 255) / KVBLK + 1;
    const int qlo = R.P0 + wid * 32, qm = qlo + r32 - 4 * hi;
    const char* gK; const char* gV0; const char* gV1;
    { const int row = tid >> 4, cp = tid & 15; gK = (const char*)R.K + row * 256 + ((cp ^ (row & 7)) << 4);
      const int sub = tid >> 5, kk = (sub >> 2) * 8 + ((tid >> 2) & 7), k = (kk & ~0xC) | ((kk & 4) << 1) | ((kk & 8) >> 1), c = (sub & 3) * 32 + (tid & 3) * 8;
      gV0 = (const char*)R.V0 + k * 256 + c * 2; gV1 = (const char*)R.V1 + k * 256 + c * 2; }
    const unsigned ldsw = (unsigned)wid * 1024u;
#define WVA_G(g, l) __builtin_amdgcn_global_load_lds((const unsigned*)(g), (SKA_LAS unsigned*)(ldsl + (l)), 16, 0, 0)
#define WVH_DMAK(T_, S_) do { const size_t go_ = (size_t)(T_) * (KVBLK * 256); const unsigned kd_ = (unsigned)(S_) * 16384u + ldsw; WVA_G(gK + go_, kd_); WVA_G(gK + go_ + 8192, kd_ + 8192); } while (0)
#define WVH_DMAV(T_, S_) do { const size_t go_ = (size_t)(T_) * (KVBLK * 256); const unsigned vd_ = 49152u + (unsigned)(S_) * 32768u + ldsw; \
        WVA_G(gV0 + go_, vd_); WVA_G(gV0 + go_ + 8192, vd_ + 8192); WVA_G(gV1 + go_, vd_ + 16384); WVA_G(gV1 + go_ + 8192, vd_ + 24576); } while (0)
    float* st = (float*)(lds + WVA_STATS) + wid * 64;
    const int vb0 = (int)(uintptr_t)(lds + 49152) + v_rd_base(lane);
    const int kb0 = r32 * 256 + ((hi << 4) ^ ((r32 & 7) << 4)), kbase = (int)(uintptr_t)lds;
#define WVA_RESC(a) do { if (__any((a) < 1.f)) { if (hi == 0) st[r32] = (a); asm volatile("s_waitcnt lgkmcnt(0)" ::: "memory");              \
        _Pragma("unroll") for (int d_ = 0; d_ < 8; ++d_) _Pragma("unroll") for (int r = 0; r < 16; ++r) o[d_][r] *= st[crow(r, hi)]; } } while (0)
    WVH_DMAK(0, 0); WVH_DMAV(0, 0); WVH_DMAK(1, 1);
    bf16x8 qr[8];
#pragma unroll
    for (int d0 = 0; d0 < 8; ++d0) qr[d0] = *reinterpret_cast<const bf16x8*>(R.Q + (size_t)(wid * 32 + r32) * D + d0 * 16 + hi * 8);
    float m_reg = -1e30f, l_reg = 0; f32x16 o[8] = {};
    float al0 = 1.f, al1 = 1.f; bf16x8 pa0 = {}, pa1 = {}, pb0 = {}, pb1 = {}; bool carry = false;
    asm volatile("s_waitcnt vmcnt(0)" ::: "memory"); __syncthreads();
    const bool typeB = wid >= 4;
    int sk = 0, skw = 2, sv = 0, svp = 2, svw = 1;
#define WVH_SCORE(H_, PA0, PA1, AL) do { f32x16 s_; float mn_; int ka_[4];                                                                      \
        _Pragma("unroll") for (int dd = 0; dd < 4; ++dd) ka_[dd] = (kb0 ^ (dd << 5)) + kbase + (H_) * 8192 + sk * 16384;                                \
        __builtin_amdgcn_s_setprio(1); wvh_qk(s_, ka_, qr); __builtin_amdgcn_s_setprio(0);                                                      \
        { const int kb_ = i * KVBLK + 32 * (H_); if (kb_ + 31 > qlo) ska_mask(s_, qm - kb_); }                                                  \
        ska_sm_a(s_, m_reg, mn_, AL); ska_sm_b(s_, AL, l_reg, PA0, PA1); SBAR(); } while (0)
#define WVH_PV(VS_, H_, PA0, PA1, AL) do { WVA_RESC(AL); SBAR(); __builtin_amdgcn_s_setprio(1); ska_pv(o, vb0 + (VS_) * 32768 + (H_) * 8192, PA0, PA1); __builtin_amdgcn_s_setprio(0); } while (0)
#pragma nounroll
    for (int i = 0; i <= NT; ++i) {
        if (i + 1 < NT) WVH_DMAV(i + 1, svw);
        if (i + 2 < NT) WVH_DMAK(i + 2, skw);
        if (carry) { WVH_PV(svp, 1, pb0, pb1, al1); carry = false; }
        if (i < NT) {
            const bool act0 = i * KVBLK <= qlo + 31, act1 = i * KVBLK + 32 <= qlo + 31;
            if (act0) WVH_SCORE(0, pa0, pa1, al0);
            if (act0) WVH_PV(sv, 0, pa0, pa1, al0);
            if (act1) WVH_SCORE(1, pb0, pb1, al1);
            if (act1) { if (typeB) carry = true; }
            if (act1 && !typeB) WVH_PV(sv, 1, pb0, pb1, al1);
        }
        if (i + 2 < NT) asm volatile("s_waitcnt vmcnt(2)" ::: "memory"); else asm volatile("s_waitcnt vmcnt(0)" ::: "memory");
        __syncthreads();
        sk = sk == 2 ? 0 : sk + 1; skw = skw == 2 ? 0 : skw + 1; svp = sv; sv = sv == 2 ? 0 : sv + 1; svw = svw == 2 ? 0 : svw + 1;
    }
#undef WVH_PV
#undef WVH_SCORE
#undef WVH_DMAK
#undef WVH_DMAV
    if (hi == 0) st[32 + r32] = l_reg; asm volatile("s_waitcnt lgkmcnt(0)" ::: "memory");
    float rli[16];
#pragma unroll
    for (int r = 0; r < 16; ++r) rli[r] = __builtin_amdgcn_rcpf(st[32 + crow(r, hi)]);
    if (cmode == 0) {
        bf16* Ow = R.O + (size_t)(wid * 32) * 256 + r32;
#pragma unroll
        for (int r = 0; r < 16; ++r) { const int orow = crow(r, hi);
#pragma unroll
            for (int d0 = 0; d0 < 8; ++d0) { const float v = o[d0][r] * rli[r]; const float vn = __shfl_xor(v, 1);
                if ((r32 & 1) == 0) *(unsigned*)(Ow + (size_t)orow * 256 + d0 * 32) = cvtpk(v, vn); } }
    } else {
        char* wl = lds + wid * 16384; const bf16* O0w = R.O + (size_t)(wid * 32) * 256;
#pragma unroll
        for (int hb = 0; hb < 2; ++hb) { u32x4 tq[8];
#pragma unroll
            for (int j = 0; j < 8; ++j) tq[j] = *reinterpret_cast<const u32x4*>(O0w + (size_t)(2 * (hb * 8 + j) + hi) * 256 + r32 * 8);
#pragma unroll
            for (int j = 0; j < 8; ++j) *reinterpret_cast<u32x4*>(wl + (2 * (hb * 8 + j) + hi) * 512 + r32 * 16) = tq[j]; }
        float sg8[8];
#pragma unroll
        for (int d0 = 0; d0 < 8; ++d0) sg8[d0] = sg[d0 * 32 + r32] * 0.8f;
        asm volatile("s_waitcnt lgkmcnt(0)" ::: "memory");
        bf16* Hw = HAo + (size_t)(wid * 32) * hap + r32;
#pragma unroll
        for (int r = 0; r < 16; ++r) { const int orow = crow(r, hi); float df[8]; float ss = 0.f;
#pragma unroll
            for (int d0 = 0; d0 < 8; ++d0) { const unsigned short h0 = *reinterpret_cast<const unsigned short*>(wl + orow * 512 + (d0 * 32 + r32) * 2);
                df[d0] = __builtin_bit_cast(float, (unsigned)h0 << 16) - lam * (o[d0][r] * rli[r]); ss += df[d0] * df[d0]; }
            ss += __shfl_xor(ss, 1); ss += __shfl_xor(ss, 2); ss += __shfl_xor(ss, 4); ss += __shfl_xor(ss, 8); ss += __shfl_xor(ss, 16);
            const float rs = 1.0f / sqrtf(ss * (1.0f / 256.f) + 1e-6f);
#pragma unroll
            for (int d0 = 0; d0 < 8; ++d0) { const float v = df[d0] * rs * sg8[d0]; const float vn = __shfl_xor(v, 1);
                if ((r32 & 1) == 0) *(unsigned*)(Hw + (size_t)orow * hap + d0 * 32) = cvtpk(v, vn); } }
        __syncthreads();
    }
#undef WVA_RESC
#undef WVA_G
}
}
constexpr int NWAVES = 8;
constexpr int BATCH = 4, SEQ = 4096, D = 2048, M = BATCH * SEQ, FF = 5632, QKVD = 6144, NH = 8, HD = 128, VD = 256;
constexpr int NGRP = 128, SGRP = 16, SST = 64, CH = 16, NCH = SEQ / CH  , SROWS = NGRP * BATCH * NCH  , SLD = 384;
constexpr float NORM_EPS = 1e-6f;
constexpr int NPH = 24;

#ifndef ATT_WVA
#define ATT_WVA 1
#endif
#ifndef ATT_SKA
#define ATT_SKA 1
#endif
#ifndef ATT_RSA
#define ATT_RSA 1
#endif
#ifndef G2_KREV
#define G2_KREV 0
#endif
#ifndef G1_SPLIT
#define G1_SPLIT 0
#endif
#ifndef G1_WGM
#define G1_WGM 8
#endif
#ifndef OTH_WGM
#define OTH_WGM 8
#endif
#ifndef G2_WGM
#define G2_WGM 4
#endif
#ifndef KPAD
#define KPAD 0
#endif
#ifndef FPAD
#define FPAD 0
#endif
constexpr int KP = D + KPAD, FP = FF + FPAD;
constexpr size_t MiB = 1u << 20;
constexpr size_t al1m(size_t x) { return (x + MiB - 1) / MiB * MiB; }
constexpr size_t WS_CTL = 0, CTL_ZERO_BYTES = 1 * MiB;
constexpr size_t WS_COEF = 1 * MiB;
constexpr size_t WS_ROPE = 2 * MiB;
constexpr size_t WS_XBUF = 4 * MiB;
constexpr size_t WS_WIN = 8 * MiB;
constexpr size_t WS_WOUT = al1m(WS_WIN + (size_t)4 * 2 * FF * KP * 2);
constexpr size_t WS_WQKV = al1m(WS_WOUT + (size_t)4 * D * FP * 2);
constexpr size_t WS_WO = al1m(WS_WQKV + (size_t)QKVD * KP * 2);
constexpr size_t WS_WGLU = al1m(WS_WO + (size_t)D * KP * 2);
constexpr size_t WS_TV = al1m(WS_WGLU + (size_t)2 * D * KP * 2);
constexpr size_t WS_SW = al1m(WS_TV + (size_t)NGRP * 256 * SLD * 2);
constexpr size_t WS_HA = al1m(WS_SW + (size_t)NGRP * 256 * 256 * 2);
constexpr size_t WS_ACT = al1m(WS_HA + (size_t)M * KP * 2);
constexpr size_t WS_QKRAW = al1m(WS_ACT + (size_t)M * FP * 2);
constexpr size_t WS_XH = WS_QKRAW;
constexpr size_t WS_QH = al1m(WS_QKRAW + (size_t)M * 4096 * 2);
constexpr size_t WS_KH = al1m(WS_QH + (size_t)M * 2048 * 2);
constexpr size_t WS_VH = al1m(WS_KH + (size_t)M * 2048 * 2);
constexpr size_t WS_OH = al1m(WS_VH + (size_t)M * 2048 * 2);
constexpr size_t WS_HS2 = al1m(WS_OH + (size_t)M * 4096 * 2);
constexpr size_t WS_SLOC = al1m(WS_HS2 + (size_t)SROWS * SLD * 2);
constexpr size_t WS_END = al1m(WS_SLOC + (size_t)SROWS * 128 * 4);
static_assert(WS_END <= (size_t)1400 * MiB, "workspace map");
constexpr int CW_TMO = 0, CW_BAR = 4096, CW_Q = 8192, CW_PCNT = 65536;

constexpr int RING_BYTES = 131072, LDSCTL_OFF = 147456, MISC_OFF = LDSCTL_OFF + 320, LDS_BYTES = 155648;

#define GAS __attribute__((address_space(1)))
#define LAS __attribute__((address_space(3)))
typedef unsigned short bf16;
typedef unsigned v4u __attribute__((ext_vector_type(4)));
typedef unsigned v2u __attribute__((ext_vector_type(2)));
typedef float f32x4 __attribute__((ext_vector_type(4)));
typedef GAS unsigned gu32;
#define RLX_AGENT __ATOMIC_RELAXED, __HIP_MEMORY_SCOPE_AGENT
#define LDS_WAIT() asm volatile("s_waitcnt lgkmcnt(0)" ::: "memory")
__device__ __forceinline__ unsigned f2bf(float f) { unsigned u = __builtin_bit_cast(unsigned, f); return (u + 0x7fffu + ((u >> 16) & 1u)) >> 16; }
__device__ __forceinline__ unsigned pk2(float lo, float hi) { return f2bf(lo) | (f2bf(hi) << 16); }
__device__ __forceinline__ float bf_lo(unsigned w) { return __builtin_bit_cast(float, w << 16); }
__device__ __forceinline__ float bf_hi(unsigned w) { return __builtin_bit_cast(float, w & 0xffff0000u); }
__device__ __forceinline__ float wave_sum(float v) {
#pragma unroll
    for (int o = 1; o < 64; o <<= 1) v += __shfl_xor(v, o);
    return v;
}

#ifndef FUSE_NORM
#define FUSE_NORM 1
#endif
#ifndef SSM_CHAIN
#define SSM_CHAIN 1
#endif
#ifndef FUSE_SSMN
#define FUSE_SSMN 1
#endif
#ifndef FUSE_GLUN
#define FUSE_GLUN 0
#endif
#ifndef PRO_WG
#define PRO_WG 1
#endif
#ifndef Q_CHUNK
#define Q_CHUNK 16
#endif
#ifndef QKV_MREV
#define QKV_MREV 0
#endif
#ifndef OTH_MREV
#define OTH_MREV 1
#endif
#ifndef G1_NREV
#define G1_NREV 0
#endif
#ifndef G1_MREV
#define G1_MREV 0
#endif
#ifndef G2_MREV
#define G2_MREV 1
#endif
#ifndef PROBE_XNAN
#define PROBE_XNAN 0
#endif
#ifndef PROBE_ATT
#define PROBE_ATT 0
#endif
#ifndef PROBE_DUP
#define PROBE_DUP -1
#endif
#define NREP(k) (((k) == PROBE_DUP || (PROBE_DUP == 200 && ((k) == 6 || (k) == 8)) || (PROBE_DUP == 201 && (k) >= 16 && (k) <= 19)) ? 2 : ((k) + 500 == PROBE_DUP ? 5 : 1))
#ifdef ONLY_PHASE
#define PH_EN(k) ((k) == (ONLY_PHASE))
#else
#define PH_EN(k) true
#endif

#define XB_TMO      128
#define XB_XCNT(j)  (256  + 64 * (j))
#define XB_XSUB(j)  (1280 + 64 * (j))
#define XB_XGEN(j)  (2304 + 64 * (j))
#define XB_TOP      3328
#define XB_TOPGEN   3392
#define XCD_BAR_WORDS 3456
#define XB_SPIN_CAP (1u << 18)

__device__ __forceinline__ unsigned xb_ld(unsigned* p)              { return __hip_atomic_load(p, __ATOMIC_RELAXED, __HIP_MEMORY_SCOPE_AGENT); }
__device__ __forceinline__ unsigned xb_add(unsigned* p, unsigned v) { return __hip_atomic_fetch_add(p, v, __ATOMIC_RELAXED, __HIP_MEMORY_SCOPE_AGENT); }
__device__ __forceinline__ unsigned xb_xcc_id() { return (unsigned)__builtin_amdgcn_s_getreg((3 << 11) | 20) & 0xFu; }
#define XB_SPIN(cond, bar) do { unsigned _sp = 0; while (cond) { __builtin_amdgcn_s_sleep(1); \
    if ((++_sp & 255u) == 0u) { if (xb_ld(&(bar)[XB_TMO])) break; if (_sp > XB_SPIN_CAP) { atomicAdd(&(bar)[XB_TMO], 1u); break; } } } } while (0)

struct XcdBarrier {
    unsigned* bar; unsigned x;
    volatile LAS unsigned* st;
};

__device__ __forceinline__ XcdBarrier xcd_barrier_post(unsigned* bar, volatile LAS unsigned* st) {
    XcdBarrier b; b.bar = bar; b.x = xb_xcc_id(); b.st = st;
    if (threadIdx.x == 0) (void)xb_add(&bar[XB_XCNT(b.x)], 1u);
    return b;
}
__device__ __forceinline__ void xcd_barrier_complete(unsigned* bar, unsigned x, unsigned& nloc, unsigned& nx) {
    const unsigned G = gridDim.x * gridDim.y * gridDim.z;
    unsigned sum, cnt, mine, sp = 0u;
    for (;;) {
        sum = 0u; cnt = 0u; mine = 0u;
#pragma unroll
        for (unsigned j = 0; j < 16; ++j) { const unsigned c = xb_ld(&bar[XB_XCNT(j)]); sum += c; cnt += (c > 0u) ? 1u : 0u; mine = (j == x) ? c : mine; }
        if (sum == G) break;
        __builtin_amdgcn_s_sleep(1);
        if ((++sp & 255u) == 0u) { if (xb_ld(&bar[XB_TMO])) break; if (sp > XB_SPIN_CAP) { atomicAdd(&bar[XB_TMO], 1u); break; } }
    }
    nloc = mine > 0u ? mine : 1u; nx = cnt > 0u ? cnt : 1u;
}

__device__ __forceinline__ void xcd_barrier(const XcdBarrier& b) {
    asm volatile("s_waitcnt vmcnt(0)" ::: "memory");
    __syncthreads();
    if (threadIdx.x == 0) {
        unsigned* bar = b.bar;
        __builtin_amdgcn_s_waitcnt(0);
        unsigned nloc = b.st[0], nx = b.st[1];
        if (nloc == 0u) { xcd_barrier_complete(bar, b.x, nloc, nx); b.st[0] = nloc; b.st[1] = nx; }
        const unsigned old = xb_add(&bar[XB_XSUB(b.x)], 1u);
        const unsigned gen = old / nloc;
        if (old + 1u == (gen + 1u) * nloc) {
            __builtin_amdgcn_fence(__ATOMIC_RELEASE, "agent");
            asm volatile("s_waitcnt vmcnt(0)" ::: "memory");
            const unsigned og = xb_add(&bar[XB_TOP], 1u);
            const unsigned tg = og / nx;
            if (og + 1u == (tg + 1u) * nx) xb_add(&bar[XB_TOPGEN], 1u);
            else XB_SPIN(xb_ld(&bar[XB_TOPGEN]) == tg, bar);
            __builtin_amdgcn_fence(__ATOMIC_ACQUIRE, "agent");
            xb_add(&bar[XB_XGEN(b.x)], 1u);
            asm volatile("s_waitcnt vmcnt(0)" ::: "memory");
        } else {
            XB_SPIN(xb_ld(&bar[XB_XGEN(b.x)]) == gen, bar);
            __builtin_amdgcn_fence(__ATOMIC_ACQUIRE, "agent");
            asm volatile("s_waitcnt vmcnt(0)" ::: "memory");
        }
    }
    __syncthreads();
}

struct Args { const float* in[23]; float* out; unsigned char* ws; int ph_lo, ph_hi; };

struct TrItem { const float* W; bf16* WT; int ldt, N, k0, n0, drow0; };
__device__ __forceinline__ void transpose_load(const TrItem& t, float (&wv)[32], int lane) {
#pragma unroll
    for (int i = 0; i < 32; ++i) { const int kk = 2 * i + (lane >> 5); wv[i] = __builtin_nontemporal_load(t.W + (size_t)(t.k0 + kk) * t.N + t.n0 + (lane & 31)); }
}
__device__ __forceinline__ void transpose_finish(const TrItem& t, const float (&wv)[32], LAS float* scr, int lane) {
#pragma unroll
    for (int i = 0; i < 32; ++i) { const int kk = 2 * i + (lane >> 5); scr[kk * 33 + (lane & 31)] = wv[i]; }
    LDS_WAIT(); asm volatile("" ::: "memory");
    const int c = lane & 7;
#pragma unroll
    for (int j = 0; j < 4; ++j) { const int n = (lane >> 3) + 8 * j; const LAS float* s = scr + (8 * c) * 33 + n;
        v4u o; o.x = pk2(s[0 * 33], s[1 * 33]); o.y = pk2(s[2 * 33], s[3 * 33]); o.z = pk2(s[4 * 33], s[5 * 33]); o.w = pk2(s[6 * 33], s[7 * 33]);
        *(GAS v4u*)(t.WT + (size_t)(t.drow0 + n) * t.ldt + t.k0 + 8 * c) = o; }
    LDS_WAIT(); asm volatile("" ::: "memory");
}
__device__ __forceinline__ int paired_row(int n0, int half_n) { const int part = n0 / half_n, j = n0 - part * half_n; return 256 * (j >> 7) + 128 * part + (j & 127); }

__device__ __forceinline__ void p0_transposes(const Args& a, LAS unsigned char* lds, int gw, int ngw, int wave, int lane) {
    LAS float* scr = (LAS float*)(lds + wave * 16384);
    constexpr int I_IN = (D / 64) * (2 * FF / 32), I_OUT = (FF / 64) * (D / 32), I_QKV = (D / 64) * (QKVD / 32), I_O = (D / 64) * (D / 32), I_GLU = (D / 64) * (2 * D / 32);
    constexpr int NITEMS = 4 * I_IN + 4 * I_OUT + I_QKV + I_O + I_GLU;
    unsigned* qctr = (unsigned*)(a.ws + WS_CTL) + CW_Q;
    for (;;) {
      int it0 = 0; if (lane == 0) it0 = (int)__hip_atomic_fetch_add(qctr, (unsigned)Q_CHUNK, __ATOMIC_RELAXED, __HIP_MEMORY_SCOPE_AGENT);
      it0 = __builtin_amdgcn_readfirstlane(it0);
      if (it0 >= NITEMS) break;
      const int itE = it0 + Q_CHUNK < NITEMS ? it0 + Q_CHUNK : NITEMS;
      auto decode = [&](int it) { TrItem t; int r = it;
        if (r < 4 * I_IN) { const int f = r / I_IN; r -= f * I_IN; const int nb = 2 * FF / 32, kb = r / nb, n0 = 32 * (r % nb);
            t = TrItem{a.in[6] + (size_t)f * D * 2 * FF, (bf16*)(a.ws + WS_WIN) + (size_t)f * 2 * FF * KP, KP, 2 * FF, 64 * kb, n0, paired_row(n0, FF)}; return t; }
        r -= 4 * I_IN;
        if (r < 4 * I_OUT) { const int f = r / I_OUT; r -= f * I_OUT; const int nb = D / 32, kb = r / nb, n0 = 32 * (r % nb);
            t = TrItem{a.in[7] + (size_t)f * FF * D, (bf16*)(a.ws + WS_WOUT) + (size_t)f * D * FP, FP, D, 64 * kb, n0, n0}; return t; }
        r -= 4 * I_OUT;
        if (r < I_QKV) { const int nb = QKVD / 32, kb = r / nb, n0 = 32 * (r % nb); t = TrItem{a.in[8], (bf16*)(a.ws + WS_WQKV), KP, QKVD, 64 * kb, n0, n0}; return t; }
        r -= I_QKV;
        if (r < I_O) { const int nb = D / 32, kb = r / nb, n0 = 32 * (r % nb); t = TrItem{a.in[9], (bf16*)(a.ws + WS_WO), KP, D, 64 * kb, n0, n0}; return t; }
        r -= I_O;
        { const int nb = 2 * D / 32, kb = r / nb, n0 = 32 * (r % nb); t = TrItem{a.in[22], (bf16*)(a.ws + WS_WGLU), KP, 2 * D, 64 * kb, n0, paired_row(n0, D)}; return t; } };
      for (int it = it0; it < itE; it += 2) {
        float wa[32], wb[32]; const TrItem ta = decode(it); const bool two = it + 1 < itE; const TrItem tb = decode(two ? it + 1 : it);
        transpose_load(ta, wa, lane); if (two) transpose_load(tb, wb, lane);
        transpose_finish(ta, wa, scr, lane); if (two) transpose_finish(tb, wb, scr, lane);
      }
    }
}

struct TrItemW { const float* W; bf16* WT; int ldt, N, k0, n0, half; };
__device__ __forceinline__ void p0_transposes_wg(const Args& a, LAS unsigned char* lds, int tid, int wave, int lane) {
    constexpr int PIT = 260;
    LAS float* T0 = (LAS float*)lds; LAS float* T1 = T0 + 64 * PIT; LAS int* tick = (LAS int*)(lds + 2 * 64 * PIT * 4);
    constexpr int J_IN = (D / 64) * (2 * FF / 256), J_OUT = (FF / 64) * (D / 256), J_QKV = (D / 64) * (QKVD / 256), J_O = (D / 64) * (D / 256), J_GLU = (D / 64) * (2 * D / 256);
    constexpr int NTK = (4 * J_IN + 4 * J_OUT + J_QKV + J_O + J_GLU) / 2;
    unsigned* qctr = (unsigned*)(a.ws + WS_CTL) + CW_Q;
    auto decode = [&](int it) { TrItemW t; int r = it;
        if (r < 4 * J_IN) { const int f = r / J_IN; r -= f * J_IN; const int nb = 2 * FF / 256; t = TrItemW{a.in[6] + (size_t)f * D * 2 * FF, (bf16*)(a.ws + WS_WIN) + (size_t)f * 2 * FF * KP, KP, 2 * FF, 64 * (r / nb), 256 * (r % nb), FF}; return t; }
        r -= 4 * J_IN;
        if (r < 4 * J_OUT) { const int f = r / J_OUT; r -= f * J_OUT; const int nb = D / 256; t = TrItemW{a.in[7] + (size_t)f * FF * D, (bf16*)(a.ws + WS_WOUT) + (size_t)f * D * FP, FP, D, 64 * (r / nb), 256 * (r % nb), 0}; return t; }
        r -= 4 * J_OUT;
        if (r < J_QKV) { const int nb = QKVD / 256; t = TrItemW{a.in[8], (bf16*)(a.ws + WS_WQKV), KP, QKVD, 64 * (r / nb), 256 * (r % nb), 0}; return t; }
        r -= J_QKV;
        if (r < J_O) { const int nb = D / 256; t = TrItemW{a.in[9], (bf16*)(a.ws + WS_WO), KP, D, 64 * (r / nb), 256 * (r % nb), 0}; return t; }
        r -= J_O;
        { const int nb = 2 * D / 256; t = TrItemW{a.in[22], (bf16*)(a.ws + WS_WGLU), KP, 2 * D, 64 * (r / nb), 256 * (r % nb), D}; return t; } };
#define TRW_LOAD(t, r) do { _Pragma("unroll") for (int i = 0; i < 8; ++i) r[i] = __builtin_nontemporal_load((const GAS f32x4*)((t).W + (size_t)((t).k0 + 8 * wave + i) * (t).N + (t).n0) + lane); } while (0)
#define TRW_WRITE(T, r) do { _Pragma("unroll") for (int i = 0; i < 8; ++i) *(LAS f32x4*)((T) + (8 * wave + i) * PIT + 4 * lane) = r[i]; } while (0)
#define TRW_OUT(T, t) do { const int n_ = lane & 31, nw_ = (t).n0 + 32 * wave, dr_ = ((t).half ? paired_row(nw_, (t).half) : nw_) + n_;                        \
        _Pragma("unroll") for (int j = 0; j < 4; ++j) { const int c_ = (lane >> 5) + 2 * j; const LAS float* s_ = (T) + (8 * c_) * PIT + 32 * wave + n_;          \
            v4u o_; o_.x = pk2(s_[0 * PIT], s_[1 * PIT]); o_.y = pk2(s_[2 * PIT], s_[3 * PIT]); o_.z = pk2(s_[4 * PIT], s_[5 * PIT]); o_.w = pk2(s_[6 * PIT], s_[7 * PIT]); \
            *(GAS v4u*)((t).WT + (size_t)dr_ * (t).ldt + (t).k0 + 8 * c_) = o_; } } while (0)
    if (tid == 0) { tick[0] = (int)__hip_atomic_fetch_add(qctr, 1u, __ATOMIC_RELAXED, __HIP_MEMORY_SCOPE_AGENT); tick[1] = (int)__hip_atomic_fetch_add(qctr, 1u, __ATOMIC_RELAXED, __HIP_MEMORY_SCOPE_AGENT); }
    __syncthreads();
    int cur = __builtin_amdgcn_readfirstlane(tick[0]), nxt = __builtin_amdgcn_readfirstlane(tick[1]);
    __syncthreads();
    f32x4 ra[8], rb[8];
    if (cur < NTK) { const TrItemW ta = decode(2 * cur), tb = decode(2 * cur + 1); TRW_LOAD(ta, ra); TRW_LOAD(tb, rb); }
    while (cur < NTK) {
        int t2 = 0; if (tid == 0) t2 = (int)__hip_atomic_fetch_add(qctr, 1u, __ATOMIC_RELAXED, __HIP_MEMORY_SCOPE_AGENT);
        const TrItemW ta = decode(2 * cur), tb = decode(2 * cur + 1);
        TRW_WRITE(T0, ra); TRW_WRITE(T1, rb);
        if (nxt < NTK) { const TrItemW na = decode(2 * nxt), nb2 = decode(2 * nxt + 1); TRW_LOAD(na, ra); TRW_LOAD(nb2, rb); }
        if (tid == 0) tick[0] = t2;
        __syncthreads();
        TRW_OUT(T0, ta); TRW_OUT(T1, tb);
        const int n2 = __builtin_amdgcn_readfirstlane(tick[0]);
        __syncthreads();
        cur = nxt; nxt = n2;
    }
#undef TRW_OUT
#undef TRW_WRITE
#undef TRW_LOAD
}

__device__ __forceinline__ void p0_adaln_task(const Args& a, LAS unsigned char* lds, int t, int tid, int wave, int lane) {
    LAS float* cond = (LAS float*)lds;
    LAS float* red = (LAS float*)(lds + 32768);
    const float* cin = a.in[1];
    for (int e = tid; e < BATCH * D; e += NWAVES * 64) { const int b = e / D, k = e - b * D; const float v = cin[e]; cond[k * 4 + b] = v / (1.0f + expf(-v)); }
    __syncthreads();
    const int i = t / 72, jc = t - i * 72, k0 = 256 * wave;
    const float* wp = a.in[4] + ((size_t)i * D + k0) * (9 * D) + jc * 256 + 4 * lane;
    f32x4 acc[4];
#pragma unroll
    for (int b = 0; b < 4; ++b) acc[b] = (f32x4){0.f, 0.f, 0.f, 0.f};
#pragma unroll 8
    for (int kk = 0; kk < 256; ++kk) { const f32x4 wv = __builtin_nontemporal_load((const GAS f32x4*)(wp + (size_t)kk * (9 * D))); const f32x4 cv = *(const LAS f32x4*)(cond + (k0 + kk) * 4);
#pragma unroll
        for (int b = 0; b < 4; ++b) acc[b] += cv[b] * wv; }
#pragma unroll
    for (int b = 0; b < 4; ++b) *(LAS f32x4*)(red + (wave * 4 + b) * 256 + 4 * lane) = acc[b];
    __syncthreads();
    float* coef = (float*)(a.ws + WS_COEF);
    for (int o = tid; o < 1024; o += NWAVES * 64) { const int b = o >> 8, cl = o & 255; float s = 0.f;
#pragma unroll
        for (int w = 0; w < 8; ++w) s += red[(w * 4 + b) * 256 + cl];
        const int col = jc * 256 + cl, sub = col / (3 * D), kind = (col / D) % 3, d = col % D;
        float v = s + a.in[5][i * 9 * D + col];
        if (kind == 1) v = a.in[3][(i * 3 + sub) * D + d] * (1.0f + v);
        if (kind == 2 && sub != 1) v *= 0.5f;
        coef[((size_t)((i * 3 + sub) * 3 + kind) * 4 + b) * D + d] = v; }
    __syncthreads();
}

__device__ __forceinline__ void ssm_disc(const Args& a, int g, int n, float& abr, float& abi, float& cfr, float& cfi) {
    const float dt = expf(a.in[16][g]), ar = a.in[14][g * SST + n], ai = a.in[15][g * SST + n];
    const float mag = expf(dt * ar); abr = mag * cosf(dt * ai); abi = mag * sinf(dt * ai);
    const float den = ar * ar + ai * ai, nre = abr - 1.0f;
    cfr = (nre * ar + abi * ai) / den; cfi = (abi * ar - nre * ai) / den;
}
__device__ __forceinline__ void p0_ssm_task(const Args& a, LAS unsigned char* lds, int g, int tid) {
    LAS float* pwr = (LAS float*)lds;
    LAS float* pwi = pwr + 17 * 64;
    LAS float* bbr = pwi + 17 * 64;
    LAS float* bbi = bbr + 1024;
    LAS float* ccr = bbi + 1024;
    LAS float* cci = ccr + 1024;
    LAS float* cfs = cci + 1024;
    LAS float* Kt = cfs + 128;
    if (tid < SST) { float abr, abi, cfr, cfi; ssm_disc(a, g, tid, abr, abi, cfr, cfi); cfs[tid * 2] = cfr; cfs[tid * 2 + 1] = cfi;
        float pr = 1.f, pi = 0.f;
        for (int l = 0; l <= 16; ++l) { pwr[l * 64 + tid] = pr; pwi[l * 64 + tid] = pi; const float nr = pr * abr - pi * abi, ni = pr * abi + pi * abr; pr = nr; pi = ni; } }
    __syncthreads();
    for (int e = tid; e < 1024; e += NWAVES * 64) { const int n = e >> 4; const float br = a.in[17][(size_t)g * 1024 + e], bi = a.in[18][(size_t)g * 1024 + e], cr = cfs[n * 2], ci = cfs[n * 2 + 1];
        bbr[e] = cr * br - ci * bi; bbi[e] = cr * bi + ci * br; ccr[e] = a.in[19][(size_t)g * 1024 + e]; cci[e] = a.in[20][(size_t)g * 1024 + e]; }
    __syncthreads();
    { const int pq = tid & 255, p = pq >> 4, q = pq & 15, l0 = (tid >> 8) * 8;
        float s[8];
#pragma unroll
        for (int j = 0; j < 8; ++j) s[j] = 0.f;
        for (int n = 0; n < SST; ++n) { const float cr = ccr[p * 64 + n], ci = cci[p * 64 + n], br = bbr[n * 16 + q], bi = bbi[n * 16 + q];
            const float er = cr * br - ci * bi, ei = cr * bi + ci * br;
#pragma unroll
            for (int j = 0; j < 8; ++j) s[j] += er * pwr[(l0 + j) * 64 + n] - ei * pwi[(l0 + j) * 64 + n]; }
        if (l0 == 0 && p == q) s[0] += a.in[21][g * SGRP + p];
#pragma unroll
        for (int j = 0; j < 8; ++j) Kt[(l0 + j) * 256 + pq] = s[j]; }
    __syncthreads();
    bf16* TV = (bf16*)(a.ws + WS_TV) + (size_t)g * 256 * SLD;
    for (int ch = tid; ch < 256 * 48; ch += NWAVES * 64) { const int row = ch / 48, kc = ch - row * 48, t = row >> 4, p = row & 15; float v[8];
        if (kc < 32) { const int tp = kc >> 1, q0 = 8 * (kc & 1);
#pragma unroll
            for (int e = 0; e < 8; ++e) v[e] = tp <= t ? Kt[((t - tp) * 16 + p) * 16 + q0 + e] : 0.f; }
        else { const int n20 = 8 * (kc - 32);
#pragma unroll
            for (int e = 0; e < 8; ++e) { const int n2 = n20 + e, n = n2 & 63; const float cr = ccr[p * 64 + n], ci = cci[p * 64 + n], pr = pwr[(t + 1) * 64 + n], pi = pwi[(t + 1) * 64 + n];
                v[e] = n2 < 64 ? (cr * pr - ci * pi) : -(cr * pi + ci * pr); } }
        v4u o; o.x = pk2(v[0], v[1]); o.y = pk2(v[2], v[3]); o.z = pk2(v[4], v[5]); o.w = pk2(v[6], v[7]);
        *(GAS v4u*)(TV + (size_t)row * SLD + 8 * kc) = o; }
    bf16* SW = (bf16*)(a.ws + WS_SW) + (size_t)g * 256 * 256;
    for (int ch = tid; ch < 256 * 32; ch += NWAVES * 64) { const int n2 = ch >> 5, kc = ch & 31, tp = kc >> 1, q0 = 8 * (kc & 1), n = n2 & 63; float v[8];
#pragma unroll
        for (int e = 0; e < 8; ++e) { const float pr = pwr[(15 - tp) * 64 + n], pi = pwi[(15 - tp) * 64 + n], br = bbr[n * 16 + q0 + e], bi = bbi[n * 16 + q0 + e];
            v[e] = n2 < 64 ? (pr * br - pi * bi) : (n2 < 128 ? (pr * bi + pi * br) : 0.f); }
        v4u o; o.x = pk2(v[0], v[1]); o.y = pk2(v[2], v[3]); o.z = pk2(v[4], v[5]); o.w = pk2(v[6], v[7]);
        *(GAS v4u*)(SW + (size_t)n2 * 256 + 8 * kc) = o; }
    __syncthreads();
}
__device__ __forceinline__ void p0_rope(const Args& a, int gtid, int ngt) {
    const int* pos = (const int*)a.in[2]; float* rope = (float*)(a.ws + WS_ROPE);
    for (int e = gtid; e < M * 16; e += ngt) { const int m = e >> 4, j = e & 15;
        const float inv = powf(500000.0f, -(float)j * (1.0f / 16.0f)), ang = (float)pos[m] * inv;
        rope[m * 32 + j] = cosf(ang); rope[m * 32 + 16 + j] = sinf(ang); }
}

typedef _Float16 f16x4v __attribute__((ext_vector_type(4)));
__device__ __forceinline__ f32x4 ldx4(const float* row, int i) { return *((const GAS f32x4*)row + i); }
__device__ __forceinline__ f32x4 ldx4(const _Float16* row, int i) { const f16x4v h = *((const GAS f16x4v*)row + i); return (f32x4){(float)h[0], (float)h[1], (float)h[2], (float)h[3]}; }
template <bool SSM, class XT>
__device__ __forceinline__ void norm_phase(const XT* x, const float* gs  , const float* sh, bf16* dst, int gw, int ngw, int lane) {
    for (int rb = gw; rb < M / 8; rb += ngw) {
        const int r0 = rb * 8, b = r0 / SEQ;
        f32x4 g4[8], s4[8];
#pragma unroll
        for (int j = 0; j < 8; ++j) { g4[j] = *((const GAS f32x4*)(gs + (size_t)b * D) + lane + 64 * j); s4[j] = *((const GAS f32x4*)(sh + (size_t)b * D) + lane + 64 * j); }
        for (int rr = 0; rr < 8; ++rr) {
            const int m = r0 + rr; const XT* xr = x + (size_t)m * D;
            f32x4 v[8]; float ss = 0.f;
#pragma unroll
            for (int j = 0; j < 8; ++j) { v[j] = ldx4(xr, lane + 64 * j); ss += (v[j].x * v[j].x + v[j].y * v[j].y) + (v[j].z * v[j].z + v[j].w * v[j].w); }
            const float rs = 1.0f / sqrtf(wave_sum(ss) * (1.0f / D) + NORM_EPS);
#pragma unroll
            for (int j = 0; j < 8; ++j) { const f32x4 h = v[j] * rs * g4[j] + s4[j]; v2u o; o.x = pk2(h.x, h.y); o.y = pk2(h.z, h.w);
                if (SSM) { const int s = m - b * SEQ, c = s >> 4, tau = s & 15, g = (lane + 64 * j) >> 2, q0 = 4 * (lane & 3);
                    *(GAS v2u*)(dst + ((size_t)((g * BATCH + b) * NCH + c)) * SLD + tau * 16 + q0) = o; }
                else *((GAS v2u*)(dst + (size_t)m * KP) + lane + 64 * j) = o; }
        }
    }
}
__device__ __forceinline__ void combine_phase(const Args& a, int gw, int ngw, int lane) {
    const bf16* OH = (const bf16*)(a.ws + WS_OH); bf16* HA = (bf16*)(a.ws + WS_HA);
    const float* lv = a.in[12];
    const float l1 = wave_sum(lv[lane] * lv[128 + lane] + lv[64 + lane] * lv[192 + lane]), l2 = wave_sum(lv[256 + lane] * lv[384 + lane] + lv[320 + lane] * lv[448 + lane]);
    const float lam = expf(l1) - expf(l2) + 0.2f;
    const int vh = lane >> 5, d = 4 * (lane & 31);
    float sg[4];
#pragma unroll
    for (int e = 0; e < 4; ++e) sg[e] = a.in[13][4 * lane + e] * 0.8f;
    for (int m = gw; m < M; m += ngw) {
        const int b = m / SEQ, s = m - b * SEQ;
#pragma unroll
        for (int h = 0; h < NH; ++h) {
            const size_t base0 = ((size_t)(((b * NH + h) * 2 + 0) * 2 + vh) * SEQ + s) * HD + d, base1 = ((size_t)(((b * NH + h) * 2 + 1) * 2 + vh) * SEQ + s) * HD + d;
            const v2u w0 = *(const GAS v2u*)(OH + base0), w1 = *(const GAS v2u*)(OH + base1);
            float df[4] = {bf_lo(w0.x) - lam * bf_lo(w1.x), bf_hi(w0.x) - lam * bf_hi(w1.x), bf_lo(w0.y) - lam * bf_lo(w1.y), bf_hi(w0.y) - lam * bf_hi(w1.y)};
            const float ss = wave_sum(df[0] * df[0] + df[1] * df[1] + df[2] * df[2] + df[3] * df[3]);
            const float rs = 1.0f / sqrtf(ss * (1.0f / VD) + NORM_EPS);
            v2u o; o.x = pk2(df[0] * rs * sg[0], df[1] * rs * sg[1]); o.y = pk2(df[2] * rs * sg[2], df[3] * rs * sg[3]);
            *(GAS v2u*)(HA + (size_t)m * KP + h * VD + 4 * lane) = o;
        }
    }
}
__device__ __forceinline__ void scan_phase(const Args& a, LAS unsigned char* lds, int bx, int G, int tid) {
    const float* SL = (const float*)(a.ws + WS_SLOC); bf16* HS = (bf16*)(a.ws + WS_HS2);
    LAS float* tot = (LAS float*)lds;
    const int seg = tid >> 6, n = tid & 63;
    pg8::StaticOrder SO; SO.init(SROWS, 256, G, bx); pg8::Unit un;
    for (int ui = 0; SO.next(ui, un); ++ui) { const int u = un.pm;
        const int g = u >> 2;
        float abr, abi, cfr, cfi; ssm_disc(a, g, n, abr, abi, cfr, cfi);
        float a16r = abr, a16i = abi;
#pragma unroll
        for (int i = 0; i < 4; ++i) { const float nr = a16r * a16r - a16i * a16i, ni = 2.f * a16r * a16i; a16r = nr; a16i = ni; }
        float a512r = a16r, a512i = a16i;
#pragma unroll
        for (int i = 0; i < 5; ++i) { const float nr = a512r * a512r - a512i * a512i, ni = 2.f * a512r * a512i; a512r = nr; a512i = ni; }
        const size_t R0 = (size_t)u * NCH + seg * 32;
        float vr[32], vi[32];
#pragma unroll
        for (int j = 0; j < 32; ++j) { vr[j] = SL[(R0 + j) * 128 + n]; vi[j] = SL[(R0 + j) * 128 + 64 + n]; }
        float tr = 0.f, ti = 0.f;
#pragma unroll
        for (int j = 0; j < 32; ++j) { const float nr = a16r * tr - a16i * ti + vr[j], ni = a16r * ti + a16i * tr + vi[j]; tr = nr; ti = ni; }
        tot[(seg * 64 + n) * 2] = tr; tot[(seg * 64 + n) * 2 + 1] = ti;
        __syncthreads();
        float cr = 0.f, ci = 0.f;
        for (int s2 = 0; s2 < seg; ++s2) { const float nr = a512r * cr - a512i * ci + tot[(s2 * 64 + n) * 2], ni = a512r * ci + a512i * cr + tot[(s2 * 64 + n) * 2 + 1]; cr = nr; ci = ni; }
#pragma unroll
        for (int j = 0; j < 32; ++j) { bf16* dst = HS + (R0 + j) * SLD + 256 + n; dst[0] = (bf16)f2bf(cr); dst[64] = (bf16)f2bf(ci);
            const float nr = a16r * cr - a16i * ci + vr[j], ni = a16r * ci + a16i * cr + vi[j]; cr = nr; ci = ni; }
        __syncthreads();
    }
}
__device__ __forceinline__ void attn_phase(const Args& a, char* lds, int bx, int G) {
    typedef att::BlockRef<att::TIN, att::TOUT> Ref;
    const att::TIN* QH = (const att::TIN*)(a.ws + WS_QH); const att::TIN* KH = (const att::TIN*)(a.ws + WS_KH); const att::TIN* VH = (const att::TIN*)(a.ws + WS_VH); att::TOUT* OH = (att::TOUT*)(a.ws + WS_OH);
    constexpr int TOTAL = BATCH * NH * 4 * 8; constexpr size_t HS_ = (size_t)SEQ * HD;
    int L = bx; if (L >= TOTAL) return;
    int pass = 0;
#define ATT_REF(r, L_, pass_) do { const int xcd_ = (L_) & 7, k_ = (L_) >> 3, bhv = xcd_ * 16 + (k_ >> 5) * 4 + ((k_ >> 3) & 3), x = k_ & 7, qb = (pass_) ? 15 - x : x; \
        r.Q = QH + (size_t)(bhv >> 1) * HS_ + (size_t)qb * att::QB * HD; r.K = KH + (size_t)(bhv >> 1) * HS_; r.V = VH + (size_t)(((bhv >> 2) << 1) | (bhv & 1)) * HS_; \
        r.O = OH + (size_t)bhv * HS_ + (size_t)qb * att::QB * HD; r.P0 = qb * att::QB; } while (0)
    Ref cur; ATT_REF(cur, L, 0);
    att::Seam<att::TIN> S;
    att::causal_swa_prime<att::TIN, att::TOUT>(cur, att::WINDOW, lds, S);
    for (;;) {
        const bool more_pass = pass == 0, more_item = L + G < TOTAL, last = !more_pass && !more_item;
        int passn = pass + 1, Ln = L;
        if (!more_pass) { passn = 0; Ln = more_item ? L + G : L; }
        Ref nxt = cur; if (!last) ATT_REF(nxt, Ln, passn);
        att::causal_swa_block<att::TIN, att::TOUT>(cur, nxt, SEQ, att::WINDOW, lds, S);
        if (last) break;
        cur = nxt; pass = passn; L = Ln;
    }
#undef ATT_REF
}

namespace att {
struct RsaRef { const bf16* Q; const bf16* K; const bf16* V0; const bf16* V1; bf16* O; int P0; };
__device__ __forceinline__ void pv2_tile(f32x16* o, int vb, bf16x8 pa0, bf16x8 pa1, bf16x8 pa2, bf16x8 pa3) {
#define TRRD(dst, off) asm volatile("ds_read_b64_tr_b16 %0, %1 offset:%2" : "=&v"(dst) : "v"(vb), "i"(off) : "memory")
#define PV2_RD(F, blk) do { constexpr int b_ = ((blk) >> 2) * 16384 + ((blk) & 3) * 512; \
        TRRD(F[0], b_); TRRD(F[1], b_ + 2048); TRRD(F[2], b_ + 4096); TRRD(F[3], b_ + 6144); TRRD(F[4], b_ + 8192); TRRD(F[5], b_ + 10240); TRRD(F[6], b_ + 12288); TRRD(F[7], b_ + 14336); } while (0)
#define PV2_MM(F, blk) do { \
        o[blk] = __builtin_amdgcn_mfma_f32_32x32x16_bf16(pa0, (bf16x8){F[0][0], F[0][1], F[0][2], F[0][3], F[1][0], F[1][1], F[1][2], F[1][3]}, o[blk], 0, 0, 0); \
        o[blk] = __builtin_amdgcn_mfma_f32_32x32x16_bf16(pa1, (bf16x8){F[2][0], F[2][1], F[2][2], F[2][3], F[3][0], F[3][1], F[3][2], F[3][3]}, o[blk], 0, 0, 0); \
        o[blk] = __builtin_amdgcn_mfma_f32_32x32x16_bf16(pa2, (bf16x8){F[4][0], F[4][1], F[4][2], F[4][3], F[5][0], F[5][1], F[5][2], F[5][3]}, o[blk], 0, 0, 0); \
        o[blk] = __builtin_amdgcn_mfma_f32_32x32x16_bf16(pa3, (bf16x8){F[6][0], F[6][1], F[6][2], F[6][3], F[7][0], F[7][1], F[7][2], F[7][3]}, o[blk], 0, 0, 0); } while (0)
#define PV2_W8() do { asm volatile("s_waitcnt lgkmcnt(8)" ::: "memory"); SBAR(); } while (0)
#define PV2_W0() do { asm volatile("s_waitcnt lgkmcnt(0)" ::: "memory"); SBAR(); } while (0)
    s16x4 fa[8], fb[8];
    asm volatile("s_waitcnt lgkmcnt(0)" : "+v"(pa0), "+v"(pa1), "+v"(pa2), "+v"(pa3) :: "memory"); SBAR();
    PV2_RD(fa, 0);
    PV2_RD(fb, 1); PV2_W8(); PV2_MM(fa, 0); SBAR();
    PV2_RD(fa, 2); PV2_W8(); PV2_MM(fb, 1); SBAR();
    PV2_RD(fb, 3); PV2_W8(); PV2_MM(fa, 2); SBAR();
    PV2_RD(fa, 4); PV2_W8(); PV2_MM(fb, 3); SBAR();
    PV2_RD(fb, 5); PV2_W8(); PV2_MM(fa, 4); SBAR();
    PV2_RD(fa, 6); PV2_W8(); PV2_MM(fb, 5); SBAR();
    PV2_RD(fb, 7); PV2_W8(); PV2_MM(fa, 6); SBAR();
    PV2_W0(); PV2_MM(fb, 7); SBAR();
#undef PV2_W0
#undef PV2_W8
#undef PV2_MM
#undef PV2_RD
#undef TRRD
}
__device__ __forceinline__ void rsa_block(const RsaRef& R, char* lds, char* stats) {
    const int tid = ptid(), wid = __builtin_amdgcn_readfirstlane(tid >> 6), lane = tid & 63, r32 = lane & 31, hi = lane >> 5;
    const bool prod = wid < 4; const int pi = wid & 3;
    const int NT = (R.P0 + 127) / KVBLK + 1;
    const int tr = tid & 255, sr = tr >> 4, sc = (tr & 15) * 8, kws = KSWZ(sr, sc * 2), vst = v_st(sr, sc);
    char* Kl = lds; char* Vl = lds + 32768; char* Pl = lds + 98304 + pi * 8192;
    float* Al = (float*)stats + pi * 192;
    const int qlo = R.P0 + pi * QBLK, qm = qlo + r32 - 4 * hi;
#define RSA_LD4(dst, S_, o_, P_, k0) do { _Pragma("unroll") for (int j_ = 0; j_ < 4; ++j_) dst[S_][(o_) + j_] = load8<bf16>((P_) + (size_t)((k0) + sr + 16 * j_) * D + sc); } while (0)
#define RSA_WR4(src, S_, o_, base_, off_) do { _Pragma("unroll") for (int j_ = 0; j_ < 4; ++j_) *(bf16x8*)((base_) + (off_) + 4096 * j_) = src[S_][(o_) + j_]; } while (0)
    if (prod) {
        bf16x8 st[2][8];
#define RSA_LOAD(S_, k0) do { RSA_LD4(st, S_, 0, R.K, k0); RSA_LD4(st, S_, 4, R.V0, k0); } while (0)
#define RSA_WRITE(b, S_) do { RSA_WR4(st, S_, 0, Kl + (b) * 16384, kws); RSA_WR4(st, S_, 4, Vl + ((b) * 2) * 16384, vst); } while (0)
#define RSA_STAGE_A(t_, B_) do { if ((t_) + 2 < NT) RSA_LOAD(B_, ((t_) + 2) * KVBLK); } while (0)
#define RSA_STAGE_B(t_, B_) do { __syncthreads(); if ((t_) + 1 < NT) { if ((t_) + 2 < NT) asm volatile("s_waitcnt vmcnt(8)" ::: "memory"); else asm volatile("s_waitcnt vmcnt(0)" ::: "memory"); RSA_WRITE(1 - (B_), 1 - (B_)); } __syncthreads(); } while (0)
        RSA_LOAD(0, 0);
        asm volatile("s_waitcnt vmcnt(0)" ::: "memory"); RSA_WRITE(0, 0);
        if (NT > 1) RSA_LOAD(1, KVBLK);
        bf16x8 qr[8];
#pragma unroll
        for (int d0 = 0; d0 < 8; ++d0) qr[d0] = load8<bf16>(R.Q + (size_t)(pi * QBLK + r32) * D + d0 * 16 + hi * 8);
        __syncthreads();
        float m_reg = -1e30f, l_reg = 0.f;
#define RSA_PROD(T_, B_) do { const int t_ = (T_); RSA_STAGE_A(t_, B_); \
            if (t_ < NT) { f32x16 p0, p1; float mn, al; bf16x8 pa0, pa1, pa2, pa3; \
                qkt<0, false>(p0, p1, Kl + (B_) * 16384, r32, hi, qr, true); \
                { const int kb_ = t_ * KVBLK; if (kb_ + KVBLK - 1 > qlo) mask_tile(p0, p1, qm - kb_, (unsigned)WINDOW); } \
                partialSM(p0, p1, m_reg, mn, al); finishSM(p0, p1, al, l_reg, pa0, pa1, pa2, pa3); \
                bf16x8* pw = (bf16x8*)(Pl + (B_) * 4096 + lane * 64); pw[0] = pa0; pw[1] = pa1; pw[2] = pa2; pw[3] = pa3; \
                { const bool any_ = __any(al < 1.f); if (hi == 0) Al[(B_) * 64 + r32] = al; if (lane == 0) Al[(B_) * 64 + 32] = any_ ? 1.f : 0.f; } } \
            RSA_STAGE_B(t_, B_); } while (0)
        for (int t = 0; t <= NT; t += 2) { RSA_PROD(t, 0); if (t + 1 <= NT) RSA_PROD(t + 1, 1); }
#undef RSA_PROD
#undef RSA_LOAD
#undef RSA_WRITE
#undef RSA_STAGE_A
#undef RSA_STAGE_B
        if (hi == 0) Al[128 + r32] = l_reg;
        __syncthreads();
    } else {
        bf16x8 st[2][4];
#define RSA_LOAD(S_, k0) do { RSA_LD4(st, S_, 0, R.V1, k0); } while (0)
#define RSA_WRITE(b, S_) do { RSA_WR4(st, S_, 0, Vl + ((b) * 2 + 1) * 16384, vst); } while (0)
#define RSA_STAGE_A(t_, B_) do { if ((t_) + 2 < NT) RSA_LOAD(B_, ((t_) + 2) * KVBLK); } while (0)
#define RSA_STAGE_B(t_, B_) do { __syncthreads(); if ((t_) + 1 < NT) { if ((t_) + 2 < NT) asm volatile("s_waitcnt vmcnt(4)" ::: "memory"); else asm volatile("s_waitcnt vmcnt(0)" ::: "memory"); RSA_WRITE(1 - (B_), 1 - (B_)); } __syncthreads(); } while (0)
        RSA_LOAD(0, 0);
        asm volatile("s_waitcnt vmcnt(0)" ::: "memory"); RSA_WRITE(0, 0);
        if (NT > 1) RSA_LOAD(1, KVBLK);
        __syncthreads();
        f32x16 o[8];
#pragma unroll
        for (int d = 0; d < 8; ++d) o[d] = f32x16{};
        const int vbase = (int)(uintptr_t)Vl + v_rd_base(lane);
#define RSA_CONS(T_, B_) do { const int t_ = (T_); RSA_STAGE_A(t_, B_); \
            if (t_ >= 1) { const bf16x8* pr = (const bf16x8*)(Pl + (1 - (B_)) * 4096 + lane * 64); const bf16x8 pa0 = pr[0], pa1 = pr[1], pa2 = pr[2], pa3 = pr[3]; \
                if (Al[(1 - (B_)) * 64 + 32] != 0.f) { _Pragma("unroll") for (int r = 0; r < 16; ++r) { const float a_ = Al[(1 - (B_)) * 64 + crow(r, hi)]; _Pragma("unroll") for (int d = 0; d < 8; ++d) o[d][r] *= a_; } } \
                pv2_tile(o, vbase + ((1 - (B_)) * 2) * 16384, pa0, pa1, pa2, pa3); } \
            RSA_STAGE_B(t_, B_); } while (0)
        for (int t = 0; t <= NT; t += 2) { RSA_CONS(t, 0); if (t + 1 <= NT) RSA_CONS(t + 1, 1); }
#undef RSA_CONS
        __syncthreads();
        float rli[16];
#pragma unroll
        for (int r = 0; r < 16; ++r) rli[r] = __builtin_amdgcn_rcpf(Al[128 + crow(r, hi)]);
        bf16* Ow = R.O + (size_t)(pi * QBLK) * 256;
#pragma unroll
        for (int r = 0; r < 16; ++r) { const int orow = crow(r, hi);
#pragma unroll
            for (int d0 = 0; d0 < 8; ++d0) { const float v = o[d0][r] * rli[r]; const float vn = __shfl_xor(v, 1);
                if ((r32 & 1) == 0) *(unsigned*)(Ow + (size_t)orow * 256 + d0 * 32 + r32) = cvtpk(v, vn); } }
    }
    __syncthreads();
#undef RSA_STAGE_A
#undef RSA_STAGE_B
#undef RSA_LOAD
#undef RSA_WRITE
#undef RSA_LD4
#undef RSA_WR4
}
}
__device__ __forceinline__ void attn_phase_rsa(const Args& a, char* lds, LAS unsigned char* lds_l, int bx, int G, int pm = 0) {
    const att::bf16* QH = (const att::bf16*)(a.ws + WS_QH); const att::bf16* KH = (const att::bf16*)(a.ws + WS_KH); const att::bf16* VH = (const att::bf16*)(a.ws + WS_VH); att::bf16* OH = (att::bf16*)(a.ws + (pm ? WS_ACT : WS_OH));
    constexpr int TOTAL = BATCH * NH * 2 * 16; constexpr size_t HS_ = (size_t)SEQ * HD;
    for (int L = bx; L < TOTAL; L += G) {
        const int xcd = L & 7, k_ = L >> 3, bhc = xcd * 8 + (k_ >> 4), x = k_ & 15, bh = bhc >> 1;
#pragma unroll 1
        for (int pass = 0; pass < 2; ++pass) { const int qb = pass ? 31 - x : x;
            att::RsaRef R; R.Q = QH + (size_t)bhc * HS_ + (size_t)qb * 128 * HD; R.K = KH + (size_t)bhc * HS_; R.V0 = VH + (size_t)(bh * 2) * HS_; R.V1 = VH + (size_t)(bh * 2 + 1) * HS_;
            R.O = OH + ((size_t)bhc * SEQ + (size_t)qb * 128) * 256; R.P0 = qb * 128;
#if ATT_SKA
            att::SkaRef K_; K_.Q = R.Q; K_.K = R.K; K_.V0 = R.V0; K_.V1 = R.V1; K_.O = R.O; K_.P0 = R.P0; K_.pm = pm;
            att::ska_block(K_, lds, (LAS unsigned char*)lds_l);
#else
            att::rsa_block(R, lds, lds + RING_BYTES + 1024);
#endif
        }
    }
}
__device__ __forceinline__ void attn_phase_wva(const Args& a, char* lds, LAS unsigned char* lds_l, int bx, int G, int lane) {
    const att::bf16* QH = (const att::bf16*)(a.ws + WS_QH); const att::bf16* KH = (const att::bf16*)(a.ws + WS_KH); const att::bf16* VH = (const att::bf16*)(a.ws + WS_VH); att::bf16* OH = (att::bf16*)(a.ws + WS_OH);
    att::bf16* HA = (att::bf16*)(a.ws + WS_HA);
    const float* lv = a.in[12];
    const float l1 = wave_sum(lv[lane] * lv[128 + lane] + lv[64 + lane] * lv[192 + lane]), l2 = wave_sum(lv[256 + lane] * lv[384 + lane] + lv[320 + lane] * lv[448 + lane]);
    const float lam = expf(l1) - expf(l2) + 0.2f;
    constexpr int TOTAL = BATCH * NH * 8; constexpr size_t HS_ = (size_t)SEQ * HD;
    for (int L = bx; L < TOTAL; L += G) {
        const int xcd = L & 7, k_ = L >> 3, bh = xcd * 4 + (k_ >> 3), x = k_ & 7, b = bh / NH, h = bh - b * NH;
#pragma unroll 1
        for (int pass = 0; pass < 4; ++pass) { const int qb = (pass >> 1) ? x : 15 - x, c = pass & 1, bhc = bh * 2 + c;
            att::SkaRef R; R.Q = QH + (size_t)bhc * HS_ + (size_t)qb * 256 * HD; R.K = KH + (size_t)bhc * HS_; R.V0 = VH + (size_t)(bh * 2) * HS_; R.V1 = VH + (size_t)(bh * 2 + 1) * HS_;
            R.O = OH + ((size_t)(bh * 2) * SEQ + (size_t)qb * 256) * 256; R.P0 = qb * 256; R.pm = 0;
            att::wva_block(R, lds, lds_l, c, lam, a.in[13], HA + ((size_t)b * SEQ + (size_t)qb * 256) * KP + h * VD, KP); }
    }
}
__device__ __forceinline__ void combine_phase_rsa(const Args& a, int gw, int ngw, int lane) {
    const bf16* OH = (const bf16*)(a.ws + WS_OH); bf16* HA = (bf16*)(a.ws + WS_HA);
    const float* lv = a.in[12];
    const float l1 = wave_sum(lv[lane] * lv[128 + lane] + lv[64 + lane] * lv[192 + lane]), l2 = wave_sum(lv[256 + lane] * lv[384 + lane] + lv[320 + lane] * lv[448 + lane]);
    const float lam = expf(l1) - expf(l2) + 0.2f;
    float sg[4];
#pragma unroll
    for (int e = 0; e < 4; ++e) sg[e] = a.in[13][4 * lane + e] * 0.8f;
    for (int m = gw; m < M; m += ngw) {
        const int b = m / SEQ, s = m - b * SEQ;
#pragma unroll
        for (int h = 0; h < NH; ++h) {
            const size_t base0 = ((size_t)((b * NH + h) * 2 + 0) * SEQ + s) * VD + 4 * lane, base1 = ((size_t)((b * NH + h) * 2 + 1) * SEQ + s) * VD + 4 * lane;
            const v2u w0 = *(const GAS v2u*)(OH + base0), w1 = *(const GAS v2u*)(OH + base1);
            float df[4] = {bf_lo(w0.x) - lam * bf_lo(w1.x), bf_hi(w0.x) - lam * bf_hi(w1.x), bf_lo(w0.y) - lam * bf_lo(w1.y), bf_hi(w0.y) - lam * bf_hi(w1.y)};
            const float ss = wave_sum(df[0] * df[0] + df[1] * df[1] + df[2] * df[2] + df[3] * df[3]);
            const float rs = 1.0f / sqrtf(ss * (1.0f / VD) + NORM_EPS);
            v2u o; o.x = pk2(df[0] * rs * sg[0], df[1] * rs * sg[1]); o.y = pk2(df[2] * rs * sg[2], df[3] * rs * sg[3]);
            *(GAS v2u*)(HA + (size_t)m * KP + h * VD + 4 * lane) = o;
        }
    }
}

__global__ void __launch_bounds__(NWAVES * 64, 2) mk_fwd(Args args) {
    extern __shared__ __attribute__((aligned(16))) unsigned char lds_raw[];
    LAS unsigned char* lds = (LAS unsigned char*)lds_raw;
    volatile LAS unsigned* MISC = (volatile LAS unsigned*)(lds + MISC_OFF);
    const int G = gridDim.x, bx = blockIdx.x, ngw = G * NWAVES;
    unsigned char* ws = args.ws;
    gu32* ctl = (gu32*)(ws + WS_CTL);
    { const int tid0 = ptid(); for (int u = tid0; u < (LDS_BYTES - LDSCTL_OFF) / 4; u += NWAVES * 64) ((LAS unsigned*)(lds + LDSCTL_OFF))[u] = 0u; }
    __syncthreads();
#define PHASE_IDS const int tid = ptid(), lane = tid & 63, wave = __builtin_amdgcn_readfirstlane(tid >> 6), gw = bx * NWAVES + wave; (void)tid; (void)lane; (void)gw
    const int lo = args.ph_lo, hi = args.ph_hi;
    XcdBarrier bar; bar.bar = (unsigned*)(ctl + CW_BAR); bar.x = 0; bar.st = nullptr;
    if (hi - lo > 1) bar = xcd_barrier_post((unsigned*)(ctl + CW_BAR), MISC + 8);
#define IN(k) (PH_EN(k) && lo <= (k) && (k) < hi)
#define SEAM(k) do { if (IN(k) && IN((k) + 1)) { xcd_barrier(bar); if (PROBE_DUP == 300) { xcd_barrier(bar); xcd_barrier(bar); } if (PROBE_DUP == 400) { for (int i_ = 0; i_ < 5; ++i_) __builtin_amdgcn_s_sleep(127); } } } while (0)
    const float* coef = (const float*)(ws + WS_COEF);
#define COEF(i, sub, kind) (coef + (size_t)(((i) * 3 + (sub)) * 3 + (kind)) * 4 * D)
    bf16* HA = (bf16*)(ws + WS_HA); bf16* ACT = (bf16*)(ws + WS_ACT);
    const bool fz = FUSE_NORM != 0 && G == 256;
    const float* xin = args.in[0]; float* xo = args.out; _Float16* xh = (_Float16*)(ws + WS_XH);

    if (IN(0)) for (int rep = 0; rep < NREP(0); ++rep) { PHASE_IDS;
        for (int t = bx; t < 144; t += G) p0_adaln_task(args, lds, t, tid, wave, lane);
        for (int t = G - 1 - bx; t < NGRP; t += G) p0_ssm_task(args, lds, t, tid);
        p0_rope(args, bx * NWAVES * 64 + tid, G * NWAVES * 64);
#if PROBE_XNAN
        for (size_t e = (size_t)bx * NWAVES * 64 + tid; e < (size_t)3 * MiB / 4; e += (size_t)G * NWAVES * 64) ((unsigned*)(ws + WS_XBUF))[e] = 0x7fc00000u;
#endif
#if PRO_WG
        __syncthreads(); p0_transposes_wg(args, lds, tid, wave, lane);
#else
        p0_transposes(args, lds, gw, ngw, wave, lane);
#endif
        if (NREP(0) > 1) __syncthreads();
    }
    SEAM(0);
#define FFN_PHASES(P, F, LI, SUB, XSRC, XDST, XI16, XO16, NRM, FN, NLI, NSUB, INST, FSSM) \
    if ((NRM) || !fz) { if (IN(P)) for (int rep = 0; rep < NREP(P); ++rep) { PHASE_IDS; norm_phase<false>(XSRC, COEF(LI, SUB, 1), COEF(LI, SUB, 0), HA, gw, ngw, lane); } \
    SEAM(P); } \
    if (IN((P) + 1)) for (int rep = 0; rep < NREP((P) + 1); ++rep) { pg8::Gemm g{HA, (const bf16*)(ws + WS_WIN) + (size_t)(F) * 2 * FF * KP, M, 2 * FF, D, KP, KP, 0}; pg8::StaticOrder S; S.init(M, 2 * FF, G, bx, G1_WGM); S.mrev = G1_MREV; S.nrev = G1_NREV; \
        pg8::EpiSwiGLU E{ACT, FP}; \
        if (G1_SPLIT) { S.i1 = G1_SPLIT; pg8::gemm_phase<pg8::EpiSwiGLU>(lds, g, S, E); xcd_barrier(bar); S.i0 = G1_SPLIT; S.i1 = 1 << 30; } \
        pg8::gemm_phase<pg8::EpiSwiGLU>(lds, g, S, E); } \
    if (IN((P) + 1) && PROBE_DUP == 100 + (P) + 1) { pg8::Gemm g{HA, (const bf16*)(ws + WS_WIN) + (size_t)(F) * 2 * FF * KP, M, 2 * FF, D, KP, KP, 0}; pg8::StaticOrder S; S.init(M, 2 * FF, G, bx); \
        pg8::EpiNull E{}; pg8::gemm_phase<pg8::EpiNull>(lds, g, S, E); } \
    SEAM((P) + 1); \
    if (IN((P) + 2)) for (int rep = 0; rep < NREP((P) + 2); ++rep) { pg8::Gemm g{ACT, (const bf16*)(ws + WS_WOUT) + (size_t)(F) * D * FP, M, D, FF, FP, FP, 0, G2_KREV}; pg8::StaticOrder S; S.init(M, D, G, bx, G2_WGM); S.mrev = G2_MREV; \
        if ((FN) && fz) { pg8::EpiResidN<XI16, FSSM> E{XSRC, (_Float16*)xh, D, COEF(LI, SUB, 2), SEQ / 256, COEF(NLI, NSUB, 1), COEF(NLI, NSUB, 0), (FSSM) ? (bf16*)(ws + WS_HS2) : HA, KP, (float*)(ws + WS_XBUF) + (size_t)(INST) * (M * 8), (unsigned*)(ctl + CW_PCNT) + (INST) * 4096, (LAS float*)(lds + RING_BYTES + 1024), BATCH, NCH, SLD}; pg8::gemm_phase<pg8::EpiResidN<XI16, FSSM>>(lds, g, S, E); } \
        else { pg8::EpiResid<XI16, XO16> E{XSRC, XDST, D, COEF(LI, SUB, 2), SEQ / 256}; pg8::gemm_phase<pg8::EpiResid<XI16, XO16>>(lds, g, S, E); } } \
    if (IN((P) + 2) && PROBE_DUP == 100 + (P) + 2) { pg8::Gemm g{ACT, (const bf16*)(ws + WS_WOUT) + (size_t)(F) * D * FP, M, D, FF, FP, FP, 0}; pg8::StaticOrder S; S.init(M, D, G, bx); \
        pg8::EpiNull E{}; pg8::gemm_phase<pg8::EpiNull>(lds, g, S, E); } \
    SEAM((P) + 2);

    FFN_PHASES(1, 0, 0, 0, xin, xh, false, true, true, FUSE_NORM != 0, 0, 1, 0, false)
    if (!fz) { if (IN(4)) for (int rep = 0; rep < (PROBE_DUP == 4 ? 5 : 1); ++rep) { PHASE_IDS; norm_phase<false>(xh, COEF(0, 1, 1), COEF(0, 1, 0), HA, gw, ngw, lane); }
    SEAM(4); }
    if (IN(5)) for (int rep = 0; rep < NREP(5); ++rep) { pg8::Gemm g{HA, (const bf16*)(ws + WS_WQKV), M, QKVD, D, KP, KP, 0}; pg8::StaticOrder S; S.init(M, QKVD, G, bx, OTH_WGM); S.mrev = QKV_MREV;
        pg8::EpiQKVN E{(bf16*)(ws + WS_QH), (bf16*)(ws + WS_KH), (bf16*)(ws + WS_VH), SEQ, args.in[10], args.in[11], (const float*)(ws + WS_ROPE), (LAS float*)(lds + RING_BYTES + 1024)};
        pg8::gemm_phase<pg8::EpiQKVN>(lds, g, S, E); }
    SEAM(5);
#if ATT_RSA
#if ATT_WVA
    if (IN(7)) for (int rep = 0; rep < NREP(7); ++rep) { PHASE_IDS; attn_phase_wva(args, (char*)lds_raw, lds, bx, G, lane); }
#else
    if (IN(7)) for (int rep = 0; rep < NREP(7); ++rep) attn_phase_rsa(args, (char*)lds_raw, lds, bx, G, rep ? PROBE_ATT : 0);
    SEAM(7);
    if (IN(8)) for (int rep = 0; rep < NREP(8); ++rep) { PHASE_IDS; combine_phase_rsa(args, gw, ngw, lane); }
#endif
#else
    if (IN(7)) for (int rep = 0; rep < NREP(7); ++rep) attn_phase(args, (char*)lds_raw, bx, G);
    SEAM(7);
    if (IN(8)) for (int rep = 0; rep < NREP(8); ++rep) { PHASE_IDS; combine_phase(args, gw, ngw, lane); }
#endif
    SEAM(8);
    if (IN(9)) { pg8::Gemm g{HA, (const bf16*)(ws + WS_WO), M, D, D, KP, KP, 0}; pg8::StaticOrder S; S.init(M, D, G, bx, fz ? 4 : OTH_WGM); S.mrev = OTH_MREV;
        if (fz) { pg8::EpiResidN<true> E{xh, (_Float16*)xh, D, COEF(0, 1, 2), SEQ / 256, COEF(0, 2, 1), COEF(0, 2, 0), HA, KP, (float*)(ws + WS_XBUF) + (size_t)1 * (M * 8), (unsigned*)(ctl + CW_PCNT) + 1 * 4096, (LAS float*)(lds + RING_BYTES + 1024)}; pg8::gemm_phase<pg8::EpiResidN<true>>(lds, g, S, E); }
        else { pg8::EpiResid<true, true> E{xh, xh, D, COEF(0, 1, 2), SEQ / 256}; pg8::gemm_phase<pg8::EpiResid<true, true>>(lds, g, S, E); } }
    SEAM(9);
    FFN_PHASES(10, 1, 0, 2, xh, xh, true, true, FUSE_NORM == 0, FUSE_NORM != 0, 1, 0, 2, false)
    FFN_PHASES(13, 2, 1, 0, xh, xh, true, true, FUSE_NORM == 0, FUSE_SSMN != 0, 1, 1, 3, true)
    if (!(FUSE_SSMN && fz)) { if (IN(16)) for (int rep = 0; rep < NREP(16); ++rep) { PHASE_IDS; norm_phase<true>(xh, COEF(1, 1, 1), COEF(1, 1, 0), (bf16*)(ws + WS_HS2), gw, ngw, lane); }
    SEAM(16); }
    if (IN(17)) for (int rep = 0; rep < NREP(17); ++rep) { pg8::Gemm g{(const bf16*)(ws + WS_HS2), (const bf16*)(ws + WS_SW), SROWS, 256, 256, SLD, 256, 4}; pg8::StaticOrder S; S.init(SROWS, 256, G, bx);
        pg8::EpiState E{(float*)(ws + WS_SLOC)}; pg8::gemm_phase<pg8::EpiState>(lds, g, S, E); }
    if (SSM_CHAIN) { if (IN(17) && IN(18)) { asm volatile("s_waitcnt vmcnt(0)" ::: "memory"); __syncthreads(); } } else SEAM(17);
    if (IN(18)) for (int rep = 0; rep < NREP(18); ++rep) { PHASE_IDS; scan_phase(args, lds, bx, G, tid); }
    if (SSM_CHAIN) { if (IN(18) && IN(19)) { asm volatile("s_waitcnt vmcnt(0)" ::: "memory"); __syncthreads(); } } else SEAM(18);
    if (IN(19)) for (int rep = 0; rep < NREP(19); ++rep) { pg8::Gemm g{(const bf16*)(ws + WS_HS2), (const bf16*)(ws + WS_TV), SROWS, 256, SLD, SLD, SLD, 4}; pg8::StaticOrder S; S.init(SROWS, 256, G, bx);
        pg8::EpiSsmY E{HA, SEQ, KP}; pg8::gemm_phase<pg8::EpiSsmY>(lds, g, S, E); }
    SEAM(19);
    if (IN(20)) { pg8::Gemm g{HA, (const bf16*)(ws + WS_WGLU), M, 2 * D, D, KP, KP, 0}; pg8::StaticOrder S; S.init(M, 2 * D, G, bx, FUSE_GLUN ? 2 : OTH_WGM); S.mrev = OTH_MREV;
        if constexpr (FUSE_GLUN != 0) { pg8::EpiGLUN<true> E{xh, (_Float16*)xh, D, COEF(1, 1, 2), SEQ / 256, COEF(1, 2, 1), COEF(1, 2, 0), HA, KP, (float*)(ws + WS_XBUF) + (size_t)4 * (M * 8), (unsigned*)(ctl + CW_PCNT) + 4 * 4096, (LAS float*)(lds + RING_BYTES + 1024)}; pg8::gemm_phase<pg8::EpiGLUN<true>>(lds, g, S, E); }
        else { pg8::EpiGLU<true, true> E{xh, xh, D, COEF(1, 1, 2), SEQ / 256}; pg8::gemm_phase<pg8::EpiGLU<true, true>>(lds, g, S, E); } }
    SEAM(20);
    FFN_PHASES(21, 3, 1, 2, xh, xo, true, false, FUSE_GLUN == 0, false, 0, 0, 3, false)
#undef IN
#undef SEAM
}

#ifndef MK_PER_PHASE
#define MK_PER_PHASE 0
#endif
extern "C" void kernel_launch(void* const* d_in, const int* in_sizes, int n_in, void* d_out, int out_size, void* d_ws, size_t ws_size, hipStream_t stream) {
    static int grid = 0;
    if (grid == 0) {
        if (n_in != 23 || in_sizes[0] != M * D || out_size != M * D || ws_size < WS_END) { fprintf(stderr, "kernel_launch: unexpected shapes (n_in %d, in0 %d, out %d, ws %zu); nothing launched\n", n_in, n_in > 0 ? in_sizes[0] : -1, out_size, ws_size); grid = -1; return; }
        int dev = 0, cus = 0, per_cu = 0;
        if (hipGetDevice(&dev) != hipSuccess || hipDeviceGetAttribute(&cus, hipDeviceAttributeMultiprocessorCount, dev) != hipSuccess) { grid = -1; return; }
        if (hipFuncSetAttribute((const void*)mk_fwd, hipFuncAttributeMaxDynamicSharedMemorySize, LDS_BYTES) != hipSuccess) { fprintf(stderr, "kernel_launch: hipFuncSetAttribute failed\n"); grid = -1; return; }
        if (hipOccupancyMaxActiveBlocksPerMultiprocessor(&per_cu, (const void*)mk_fwd, NWAVES * 64, LDS_BYTES) != hipSuccess || per_cu < 1) { fprintf(stderr, "kernel_launch: occupancy query says %d blocks per CU\n", per_cu); }
        (void)hipGetLastError();
        grid = cus;
    }
    if (grid < 0) return;
    (void)hipMemsetAsync((char*)d_ws + WS_CTL, 0, CTL_ZERO_BYTES, stream);
    Args a{};
    for (int i = 0; i < 23; ++i) a.in[i] = (const float*)d_in[i];
    a.out = (float*)d_out; a.ws = (unsigned char*)d_ws;
#if MK_PER_PHASE
    for (int p = 0; p < NPH; ++p) { a.ph_lo = p; a.ph_hi = p + 1; hipLaunchKernelGGL(mk_fwd, dim3(grid), dim3(NWAVES * 64), LDS_BYTES, stream, a); }
#else
    a.ph_lo = 0; a.ph_hi = NPH; hipLaunchKernelGGL(mk_fwd, dim3(grid), dim3(NWAVES * 64), LDS_BYTES, stream, a);
#endif
}
```

```cpp
#include <hip/hip_runtime.h>
#include <hip/hip_bf16.h>
#include <cstdio>
#include <cstdint>
__device__ __forceinline__ int ptid() { int t = threadIdx.x; asm volatile("" : "+v"(t)); return t; }
#ifndef PG8_DMA_AFTER_READS
#define PG8_DMA_AFTER_READS 0
#endif
#ifndef PG8_DMA_IN_MMA
#define PG8_DMA_IN_MMA 1
#endif
#ifndef PG8_USE_SP2
#define PG8_USE_SP2 1
#endif
namespace pg8 {
#define PG8_LAS __attribute__((address_space(3)))
typedef unsigned short bf16_t;
typedef short bf16x8 __attribute__((ext_vector_type(8)));
typedef float f32x4 __attribute__((ext_vector_type(4)));
typedef float f32x2 __attribute__((ext_vector_type(2)));
typedef unsigned u32x4 __attribute__((ext_vector_type(4)));
constexpr int BM = 256, BK = 64, HALF = 128, HTB = HALF * BK * 2  , STAGE_BYTES = 8 * HTB, NXCD = 8, WGM = 8;

__host__ __device__ __forceinline__ int lds_byte(int r, int c) { const int st = (r >> 4) * 2 + (c >> 5), rr = r & 15, cc = c & 31, ob = rr * 64 + cc * 2; return st * 1024 + (ob ^ (((ob >> 9) & 1) << 5)); }
__host__ __device__ __forceinline__ void stage_rc(int b, int& R, int& C) { const int st = b / 1024, sb = b % 1024, swz = sb ^ (((sb >> 9) & 1) << 5); R = (st >> 1) * 16 + swz / 64; C = (st & 1) * 32 + (swz % 64) / 2; }
__host__ __device__ __forceinline__ int perm32(int rho) { const int n = rho >> 4, i = rho & 15; return 8 * (i >> 2) + 4 * n + (i & 3); }

struct Unit { int pm, pn; };
struct Gemm { const bf16_t* A; const bf16_t* Bt; int M, N, K, lda, ldb, grp; int krev = 0; };

struct StaticOrder {
    int nM, nN, nwg, G, c, wgm, i0 = 0, i1 = 1 << 30, nrev = 0  , mrev = 0;
    __host__ __device__ void init(int M, int N, int G_, int c_, int wgm_ = WGM) { nM = M / BM; nN = N / BM; nwg = nM * nN; G = G_; c = c_; wgm = wgm_; }
    __host__ __device__ bool next(int i_, Unit& u) const {
        const int i = i_ + i0; if (i >= i1) return false;
        const long L = (long)i * G + c; if (L >= nwg) return false;
        int wgid = (int)L; { const int q = nwg / NXCD, r = nwg % NXCD, xcd = wgid % NXCD, off = wgid / NXCD; wgid = (xcd < r ? xcd * (q + 1) : r * (q + 1) + (xcd - r) * q) + off; }
        const int nig = wgm * nN, gid = wgid / nig, fm = gid * wgm, gsz = (nM - fm) < wgm ? (nM - fm) : wgm;
        u.pm = fm + ((wgid % nig) % gsz); u.pn = (wgid % nig) / gsz; if (mrev == 1) u.pm = nM - 1 - u.pm; else if (mrev == 2) u.pm = (u.pm + nM / 2) % nM; else if (mrev == 3) u.pm = (u.pm & ~7) | (7 - (u.pm & 7)); if (nrev) u.pn = nN - 1 - u.pn; return true;
    }
};

__device__ __forceinline__ unsigned cvt_pk_bf16(float lo, float hi) { unsigned r; asm volatile("v_cvt_pk_bf16_f32 %0, %1, %2" : "=v"(r) : "v"(lo), "v"(hi)); return r; }
__device__ __forceinline__ float sigmoidf_fast(float v) { return __builtin_amdgcn_rcpf(1.0f + __builtin_amdgcn_exp2f(-1.4426950408889634f * v)); }

struct EpiSwiGLU {
    static constexpr bool PERM = true;
    bf16_t* O; int ldc;
    __device__ __forceinline__ void operator()(const f32x4 (&acc)[2][2][4][2], const Unit& u, int wr, int wc, int fr, int fq) const {
        asm volatile("" : "+v"(fr), "+v"(fq));
        const int row0 = u.pm * BM + wr * 64 + fr, col0 = u.pn * HALF + wc * 32 + 8 * fq;
#pragma unroll
        for (int ai = 0; ai < 2; ++ai)
#pragma unroll
            for (int m = 0; m < 4; ++m) { bf16_t* rowp = O + (size_t)(row0 + ai * HALF + m * 16) * ldc + col0;
                float r[8];
#pragma unroll
                for (int n = 0; n < 2; ++n)
#pragma unroll
                    for (int j = 0; j < 4; ++j) { const float a = acc[ai][0][m][n][j], b = acc[ai][1][m][n][j]; r[n * 4 + j] = a * sigmoidf_fast(a) * b; }
                u32x4 w; w.x = cvt_pk_bf16(r[0], r[1]); w.y = cvt_pk_bf16(r[2], r[3]); w.z = cvt_pk_bf16(r[4], r[5]); w.w = cvt_pk_bf16(r[6], r[7]);
#if defined(ACT_NT) && ACT_NT
                __builtin_nontemporal_store(w, (u32x4*)rowp);
#else
                *(u32x4*)rowp = w;
#endif
            }
    }
};
typedef _Float16 f16x4 __attribute__((ext_vector_type(4)));
typedef _Float16 f16x8 __attribute__((ext_vector_type(8)));
template <bool F16> struct XIo;
template <> struct XIo<false> { typedef float T;
    static __device__ __forceinline__ void ld8(const float* p, f32x4& a, f32x4& b) { a = *(const f32x4*)p; b = *(const f32x4*)(p + 4); }
    static __device__ __forceinline__ void st8(float* p, const f32x4& a, const f32x4& b) { *(f32x4*)p = a; *(f32x4*)(p + 4) = b; } };
template <> struct XIo<true> { typedef _Float16 T;
    static __device__ __forceinline__ void ld8(const _Float16* p, f32x4& a, f32x4& b) { const f16x8 h = *(const f16x8*)p; a = (f32x4){(float)h[0], (float)h[1], (float)h[2], (float)h[3]}; b = (f32x4){(float)h[4], (float)h[5], (float)h[6], (float)h[7]}; }
    static __device__ __forceinline__ void st8(_Float16* p, const f32x4& a, const f32x4& b) { f16x8 h; h[0] = (_Float16)a[0]; h[1] = (_Float16)a[1]; h[2] = (_Float16)a[2]; h[3] = (_Float16)a[3]; h[4] = (_Float16)b[0]; h[5] = (_Float16)b[1]; h[6] = (_Float16)b[2]; h[7] = (_Float16)b[3]; *(f16x8*)p = h; } };
template <bool I16, bool SSM = false> struct EpiResidN {
    static constexpr bool PERM = true;
    const typename XIo<I16>::T* xin; _Float16* out; int ldc; const float* coef  ; int tiles_per_batch;
    const float* gs; const float* sh  ; bf16_t* hn; int ldh;
    float* xbuf  ; unsigned* cnt  ; PG8_LAS float* tbl  ; int nb = 0, nch = 0, sld = 0;
    __device__ __forceinline__ void operator()(f32x4 (&acc)[2][2][4][2], const Unit& u, int wr, int wc, int fr, int fq) const {
        asm volatile("" : "+v"(fr), "+v"(fq));
        const int wid = wr * 4 + wc, lane = fq * 16 + fr;
        const int row0 = u.pm * BM + wr * 64 + fr, col0 = u.pn * BM + wc * 32 + 8 * fq, bb = u.pm / tiles_per_batch;
        { const float* cf = coef + (size_t)bb * ldc + col0;
          f32x4 cv[2][2];
#pragma unroll
          for (int bj = 0; bj < 2; ++bj)
#pragma unroll
              for (int n = 0; n < 2; ++n) cv[bj][n] = *(const f32x4*)(cf + bj * HALF + 4 * n);
#pragma unroll
          for (int ai = 0; ai < 2; ++ai)
#pragma unroll
            for (int mh = 0; mh < 2; ++mh) { f32x4 xv[2][2][2];
#pragma unroll
              for (int m = 0; m < 2; ++m)
#pragma unroll
                  for (int bj = 0; bj < 2; ++bj) XIo<I16>::ld8(xin + (size_t)(row0 + ai * HALF + (2 * mh + m) * 16) * ldc + col0 + bj * HALF, xv[m][bj][0], xv[m][bj][1]);
#pragma unroll
              for (int m = 0; m < 2; ++m)
#pragma unroll
                  for (int bj = 0; bj < 2; ++bj) { const int mm = 2 * mh + m; acc[ai][bj][mm][0] = xv[m][bj][0] + cv[bj][0] * acc[ai][bj][mm][0]; acc[ai][bj][mm][1] = xv[m][bj][1] + cv[bj][1] * acc[ai][bj][mm][1];
                      XIo<true>::st8(out + (size_t)(row0 + ai * HALF + mm * 16) * ldc + col0 + bj * HALF, acc[ai][bj][mm][0], acc[ai][bj][mm][1]); }
              asm volatile("" ::: "memory"); } }
#pragma unroll
        for (int ai = 0; ai < 2; ++ai)
#pragma unroll
            for (int m = 0; m < 4; ++m) { float q = 0.f;
#pragma unroll
                for (int bj = 0; bj < 2; ++bj)
#pragma unroll
                    for (int n = 0; n < 2; ++n) { const f32x4 x = acc[ai][bj][m][n]; q += (x[0] * x[0] + x[1] * x[1]) + (x[2] * x[2] + x[3] * x[3]); }
                q += __shfl_xor(q, 16); q += __shfl_xor(q, 32);
                if (fq == 0) tbl[(ai * HALF + wr * 64 + m * 16 + fr) * 4 + wc] = q; }
        asm volatile("s_waitcnt lgkmcnt(0)" ::: "memory"); __builtin_amdgcn_s_barrier(); asm volatile("" ::: "memory");
        const int row = wid * 32 + (lane & 31);
        if (lane < 32) { const float t = (tbl[row * 4 + 0] + tbl[row * 4 + 1]) + (tbl[row * 4 + 2] + tbl[row * 4 + 3]);
            __hip_atomic_store((unsigned*)xbuf + ((size_t)(u.pm * BM + row) * 8 + u.pn), __builtin_bit_cast(unsigned, t), __ATOMIC_RELAXED, __HIP_MEMORY_SCOPE_AGENT); }
        asm volatile("s_waitcnt vmcnt(0)" ::: "memory");
        if (lane == 0) __hip_atomic_fetch_add(cnt + 64 * u.pm, 1u, __ATOMIC_RELAXED, __HIP_MEMORY_SCOPE_AGENT);
        if (wid == 0) { unsigned spins = 0u;
            while ((unsigned)__builtin_amdgcn_readfirstlane(__hip_atomic_load(cnt + 64 * u.pm, __ATOMIC_RELAXED, __HIP_MEMORY_SCOPE_AGENT)) < 64u) { __builtin_amdgcn_s_sleep(2); if (++spins > (1u << 22)) break; }
            __builtin_amdgcn_fence(__ATOMIC_ACQUIRE, "agent"); }
        asm volatile("s_waitcnt vmcnt(0) lgkmcnt(0)" ::: "memory"); __builtin_amdgcn_s_barrier(); asm volatile("" ::: "memory");
        if (lane < 32) { const unsigned* slot = (const unsigned*)xbuf + (size_t)(u.pm * BM + row) * 8; float q = 0.f;
#pragma unroll
            for (int t = 0; t < 8; ++t) q += __builtin_bit_cast(float, __hip_atomic_load(slot + t, __ATOMIC_RELAXED, __HIP_MEMORY_SCOPE_AGENT));
            tbl[1024 + row] = 1.0f / sqrtf(q * (1.0f / 2048.0f) + 1e-6f); }
        asm volatile("s_waitcnt lgkmcnt(0)" ::: "memory"); __builtin_amdgcn_s_barrier(); asm volatile("" ::: "memory");
        { const float* gp = gs + (size_t)bb * ldc + col0; const float* sp = sh + (size_t)bb * ldc + col0;
          f32x4 gv[2][2], sv[2][2];
#pragma unroll
          for (int bj = 0; bj < 2; ++bj)
#pragma unroll
              for (int n = 0; n < 2; ++n) { gv[bj][n] = *(const f32x4*)(gp + bj * HALF + 4 * n); sv[bj][n] = *(const f32x4*)(sp + bj * HALF + 4 * n); }
#pragma unroll
          for (int ai = 0; ai < 2; ++ai)
#pragma unroll
              for (int m = 0; m < 4; ++m) { const int rl = ai * HALF + wr * 64 + m * 16 + fr; const float rs = tbl[1024 + rl];
                  bf16_t* hp; size_t bjs = HALF;
                  if constexpr (SSM) { const int sq = (u.pm % tiles_per_batch) * BM + rl, ch = sq >> 4, tau = sq & 15;
                      hp = hn + ((size_t)((col0 >> 4) * nb + bb) * nch + ch) * sld + tau * 16 + (col0 & 15); bjs = (size_t)(HALF / 16) * nb * nch * sld; }
                  else hp = hn + (size_t)(u.pm * BM + rl) * ldh + col0;
#pragma unroll
                  for (int bj = 0; bj < 2; ++bj) { const f32x4 h0 = acc[ai][bj][m][0] * rs * gv[bj][0] + sv[bj][0], h1 = acc[ai][bj][m][1] * rs * gv[bj][1] + sv[bj][1];
                      u32x4 w; w.x = cvt_pk_bf16(h0[0], h0[1]); w.y = cvt_pk_bf16(h0[2], h0[3]); w.z = cvt_pk_bf16(h1[0], h1[1]); w.w = cvt_pk_bf16(h1[2], h1[3]);
                      *(u32x4*)(hp + bj * bjs) = w; } } }
    }
};
template <bool I16, bool O16> struct EpiResid {
    static constexpr bool PERM = true;
    const typename XIo<I16>::T* xin; typename XIo<O16>::T* out; int ldc; const float* coef  ; int tiles_per_batch;
    __device__ __forceinline__ void operator()(const f32x4 (&acc)[2][2][4][2], const Unit& u, int wr, int wc, int fr, int fq) const {
        asm volatile("" : "+v"(fr), "+v"(fq));
        const int row0 = u.pm * BM + wr * 64 + fr, col0 = u.pn * BM + wc * 32 + 8 * fq;
        const float* cf = coef + (size_t)(u.pm / tiles_per_batch) * ldc + col0;
        f32x4 cv[2][2];
#pragma unroll
        for (int bj = 0; bj < 2; ++bj)
#pragma unroll
            for (int n = 0; n < 2; ++n) cv[bj][n] = *(const f32x4*)(cf + bj * HALF + 4 * n);
#pragma unroll
        for (int ai = 0; ai < 2; ++ai) { f32x4 xv[4][2][2];
#pragma unroll
            for (int m = 0; m < 4; ++m)
#pragma unroll
                for (int bj = 0; bj < 2; ++bj) XIo<I16>::ld8(xin + (size_t)(row0 + ai * HALF + m * 16) * ldc + col0 + bj * HALF, xv[m][bj][0], xv[m][bj][1]);
#pragma unroll
            for (int m = 0; m < 4; ++m)
#pragma unroll
                for (int bj = 0; bj < 2; ++bj) XIo<O16>::st8(out + (size_t)(row0 + ai * HALF + m * 16) * ldc + col0 + bj * HALF, xv[m][bj][0] + cv[bj][0] * acc[ai][bj][m][0], xv[m][bj][1] + cv[bj][1] * acc[ai][bj][m][1]); }
    }
};
template <bool I16> struct EpiGLUN {
    static constexpr bool PERM = true;
    const typename XIo<I16>::T* xin; _Float16* out; int ldc; const float* coef; int tiles_per_batch;
    const float* gs; const float* sh; bf16_t* hn; int ldh; float* xbuf; unsigned* cnt; PG8_LAS float* tbl;
    __device__ __forceinline__ void operator()(f32x4 (&acc)[2][2][4][2], const Unit& u, int wr, int wc, int fr, int fq) const {
        asm volatile("" : "+v"(fr), "+v"(fq));
        const int wid = wr * 4 + wc, lane = fq * 16 + fr;
        const int row0 = u.pm * BM + wr * 64 + fr, col0 = u.pn * HALF + wc * 32 + 8 * fq, bb = u.pm / tiles_per_batch;
        { const float* cf = coef + (size_t)bb * ldc + col0;
          f32x4 cv[2];
#pragma unroll
          for (int n = 0; n < 2; ++n) cv[n] = *(const f32x4*)(cf + 4 * n);
#pragma unroll
          for (int ai = 0; ai < 2; ++ai) { f32x4 xv[4][2];
#pragma unroll
              for (int m = 0; m < 4; ++m) XIo<I16>::ld8(xin + (size_t)(row0 + ai * HALF + m * 16) * ldc + col0, xv[m][0], xv[m][1]);
#pragma unroll
              for (int m = 0; m < 4; ++m) {
#pragma unroll
                  for (int n = 0; n < 2; ++n) { const f32x4 v = acc[ai][0][m][n], g = acc[ai][1][m][n]; f32x4 o;
#pragma unroll
                      for (int j = 0; j < 4; ++j) o[j] = xv[m][n][j] + cv[n][j] * v[j] * sigmoidf_fast(g[j]);
                      acc[ai][0][m][n] = o; }
                  XIo<true>::st8(out + (size_t)(row0 + ai * HALF + m * 16) * ldc + col0, acc[ai][0][m][0], acc[ai][0][m][1]); }
              asm volatile("" ::: "memory"); } }
#pragma unroll
        for (int ai = 0; ai < 2; ++ai)
#pragma unroll
            for (int m = 0; m < 4; ++m) { float q = 0.f;
#pragma unroll
                for (int n = 0; n < 2; ++n) { const f32x4 x = acc[ai][0][m][n]; q += (x[0] * x[0] + x[1] * x[1]) + (x[2] * x[2] + x[3] * x[3]); }
                q += __shfl_xor(q, 16); q += __shfl_xor(q, 32);
                if (fq == 0) tbl[(ai * HALF + wr * 64 + m * 16 + fr) * 4 + wc] = q; }
        asm volatile("s_waitcnt lgkmcnt(0)" ::: "memory"); __builtin_amdgcn_s_barrier(); asm volatile("" ::: "memory");
        const int row = wid * 32 + (lane & 31);
        if (lane < 32) { const float t = (tbl[row * 4 + 0] + tbl[row * 4 + 1]) + (tbl[row * 4 + 2] + tbl[row * 4 + 3]);
            __hip_atomic_store((unsigned*)xbuf + ((size_t)(u.pm * BM + row) * 16 + u.pn), __builtin_bit_cast(unsigned, t), __ATOMIC_RELAXED, __HIP_MEMORY_SCOPE_AGENT); }
        asm volatile("s_waitcnt vmcnt(0)" ::: "memory");
        if (lane == 0) __hip_atomic_fetch_add(cnt + 64 * u.pm, 1u, __ATOMIC_RELAXED, __HIP_MEMORY_SCOPE_AGENT);
        if (wid == 0) { unsigned spins = 0u;
            while ((unsigned)__builtin_amdgcn_readfirstlane(__hip_atomic_load(cnt + 64 * u.pm, __ATOMIC_RELAXED, __HIP_MEMORY_SCOPE_AGENT)) < 128u) { __builtin_amdgcn_s_sleep(2); if (++spins > (1u << 22)) break; }
            __builtin_amdgcn_fence(__ATOMIC_ACQUIRE, "agent"); }
        asm volatile("s_waitcnt vmcnt(0) lgkmcnt(0)" ::: "memory"); __builtin_amdgcn_s_barrier(); asm volatile("" ::: "memory");
        if (lane < 32) { const unsigned* slot = (const unsigned*)xbuf + (size_t)(u.pm * BM + row) * 16; float q = 0.f;
#pragma unroll
            for (int t = 0; t < 16; ++t) q += __builtin_bit_cast(float, __hip_atomic_load(slot + t, __ATOMIC_RELAXED, __HIP_MEMORY_SCOPE_AGENT));
            tbl[1024 + row] = 1.0f / sqrtf(q * (1.0f / 2048.0f) + 1e-6f); }
        asm volatile("s_waitcnt lgkmcnt(0)" ::: "memory"); __builtin_amdgcn_s_barrier(); asm volatile("" ::: "memory");
        { const float* gp = gs + (size_t)bb * ldc + col0; const float* sp = sh + (size_t)bb * ldc + col0;
          f32x4 gv[2], sv[2];
#pragma unroll
          for (int n = 0; n < 2; ++n) { gv[n] = *(const f32x4*)(gp + 4 * n); sv[n] = *(const f32x4*)(sp + 4 * n); }
#pragma unroll
          for (int ai = 0; ai < 2; ++ai)
#pragma unroll
              for (int m = 0; m < 4; ++m) { const int rl = ai * HALF + wr * 64 + m * 16 + fr; const float rs = tbl[1024 + rl];
                  const f32x4 h0 = acc[ai][0][m][0] * rs * gv[0] + sv[0], h1 = acc[ai][0][m][1] * rs * gv[1] + sv[1];
                  u32x4 w; w.x = cvt_pk_bf16(h0[0], h0[1]); w.y = cvt_pk_bf16(h0[2], h0[3]); w.z = cvt_pk_bf16(h1[0], h1[1]); w.w = cvt_pk_bf16(h1[2], h1[3]);
                  *(u32x4*)(hn + (size_t)(u.pm * BM + rl) * ldh + col0) = w; } }
    }
};
template <bool I16, bool O16> struct EpiGLU {
    static constexpr bool PERM = true;
    const typename XIo<I16>::T* xin; typename XIo<O16>::T* out; int ldc; const float* coef; int tiles_per_batch;
    __device__ __forceinline__ void operator()(const f32x4 (&acc)[2][2][4][2], const Unit& u, int wr, int wc, int fr, int fq) const {
        asm volatile("" : "+v"(fr), "+v"(fq));
        const int row0 = u.pm * BM + wr * 64 + fr, col0 = u.pn * HALF + wc * 32 + 8 * fq;
        const float* cf = coef + (size_t)(u.pm / tiles_per_batch) * ldc + col0;
        f32x4 cv[2];
#pragma unroll
        for (int n = 0; n < 2; ++n) cv[n] = *(const f32x4*)(cf + 4 * n);
        f32x4 xv[2][4][2];
#pragma unroll
        for (int ai = 0; ai < 2; ++ai)
#pragma unroll
            for (int m = 0; m < 4; ++m) XIo<I16>::ld8(xin + (size_t)(row0 + ai * HALF + m * 16) * ldc + col0, xv[ai][m][0], xv[ai][m][1]);
#pragma unroll
        for (int ai = 0; ai < 2; ++ai)
#pragma unroll
            for (int m = 0; m < 4; ++m) { f32x4 o[2];
#pragma unroll
                for (int n = 0; n < 2; ++n) { const f32x4 v = acc[ai][0][m][n], g = acc[ai][1][m][n];
#pragma unroll
                    for (int j = 0; j < 4; ++j) o[n][j] = xv[ai][m][n][j] + cv[n][j] * v[j] * sigmoidf_fast(g[j]); }
                XIo<O16>::st8(out + (size_t)(row0 + ai * HALF + m * 16) * ldc + col0, o[0], o[1]); }
    }
};
struct EpiQKVN {
    static constexpr bool PERM = true;
    bf16_t* QH; bf16_t* KH; bf16_t* V; int seq; const float* gq; const float* gk; const float* rope; PG8_LAS float* red;
    __device__ __forceinline__ void operator()(const f32x4 (&acc)[2][2][4][2], const Unit& u, int wr, int wc, int fr, int fq) const {
        asm volatile("" : "+v"(fr), "+v"(fq));
        const int row0 = u.pm * BM + wr * 64 + fr, cin = wc * 32 + 8 * fq;
        if (u.pn >= 16) {
            const int h = u.pn - 16;
#pragma unroll
            for (int ai = 0; ai < 2; ++ai)
#pragma unroll
                for (int m = 0; m < 4; ++m) { const int row = row0 + ai * HALF + m * 16, b = row / seq, s = row - b * seq;
#pragma unroll
                    for (int bj = 0; bj < 2; ++bj) { const f32x4 v0 = acc[ai][bj][m][0], v1 = acc[ai][bj][m][1];
                        u32x4 w; w.x = cvt_pk_bf16(v0[0], v0[1]); w.y = cvt_pk_bf16(v0[2], v0[3]); w.z = cvt_pk_bf16(v1[0], v1[1]); w.w = cvt_pk_bf16(v1[2], v1[3]);
                        *(u32x4*)(V + ((size_t)(((b * 8 + h) * 2 + bj)) * seq + s) * 128 + cin) = w; } }
            return;
        }
        const int isk = u.pn >> 3, h = u.pn & 7;
#pragma unroll
        for (int ai = 0; ai < 2; ++ai)
#pragma unroll
            for (int m = 0; m < 4; ++m)
#pragma unroll
                for (int bj = 0; bj < 2; ++bj) { const f32x4 a = acc[ai][bj][m][0], b = acc[ai][bj][m][1];
                    float ss = (a[0] * a[0] + a[1] * a[1]) + (a[2] * a[2] + a[3] * a[3]) + (b[0] * b[0] + b[1] * b[1]) + (b[2] * b[2] + b[3] * b[3]);
                    ss += __shfl_xor(ss, 16); ss += __shfl_xor(ss, 32);
                    if (fq == 0) red[((ai * HALF + wr * 64 + m * 16 + fr) * 2 + bj) * 4 + wc] = ss; }
        asm volatile("s_waitcnt lgkmcnt(0)" ::: "memory"); __builtin_amdgcn_s_barrier(); asm volatile("" ::: "memory");
        const float* gg = (isk ? gk : gq) + cin;
        const f32x4 g0 = *(const f32x4*)gg, g1 = *(const f32x4*)(gg + 4);
        bf16_t* dstb = isk ? KH : QH;
#pragma unroll
        for (int ai = 0; ai < 2; ++ai)
#pragma unroll
            for (int m = 0; m < 4; ++m) { const int rl = ai * HALF + wr * 64 + m * 16 + fr, row = u.pm * BM + rl, b = row / seq, s = row - b * seq;
                f32x4 c0, c1, s0, s1;
                if (wc == 0) { const float* rp = rope + (size_t)row * 32 + 8 * (fq & 1); c0 = *(const f32x4*)rp; c1 = *(const f32x4*)(rp + 4); s0 = *(const f32x4*)(rp + 16); s1 = *(const f32x4*)(rp + 20); }
#pragma unroll
                for (int bj = 0; bj < 2; ++bj) { const f32x4 p = *(const PG8_LAS f32x4*)(red + (rl * 2 + bj) * 4);
                    const float rs = 1.0f / sqrtf(((p[0] + p[1]) + (p[2] + p[3])) * (1.0f / 128.0f) + 1e-6f);
                    f32x4 y0 = acc[ai][bj][m][0] * rs * g0, y1 = acc[ai][bj][m][1] * rs * g1;
                    if (wc == 0) {
                        f32x4 o0, o1;
#pragma unroll
                        for (int j = 0; j < 4; ++j) { o0[j] = __shfl_xor(y0[j], 32); o1[j] = __shfl_xor(y1[j], 32); }
                        if (fq < 2) { y0 = y0 * c0 - o0 * s0; y1 = y1 * c1 - o1 * s1; } else { y0 = y0 * c0 + o0 * s0; y1 = y1 * c1 + o1 * s1; }
                    }
                    u32x4 w; w.x = cvt_pk_bf16(y0[0], y0[1]); w.y = cvt_pk_bf16(y0[2], y0[3]); w.z = cvt_pk_bf16(y1[0], y1[1]); w.w = cvt_pk_bf16(y1[2], y1[3]);
                    *(u32x4*)(dstb + ((size_t)((b * 8 + h) * 2 + bj) * seq + s) * 128 + cin) = w; } }
    }
};
struct EpiState {
    static constexpr bool PERM = false;
    float* S;
    __device__ __forceinline__ void operator()(const f32x4 (&acc)[2][2][4][2], const Unit& u, int wr, int wc, int fr, int fq) const {
        asm volatile("" : "+v"(fr), "+v"(fq));
        const int row0 = u.pm * BM + wr * 64 + fr, col0 = wc * 32 + 4 * fq;
#pragma unroll
        for (int ai = 0; ai < 2; ++ai)
#pragma unroll
            for (int m = 0; m < 4; ++m) { float* rowp = S + (size_t)(row0 + ai * HALF + m * 16) * 128 + col0;
#pragma unroll
                for (int n = 0; n < 2; ++n) *(f32x4*)(rowp + n * 16) = acc[ai][0][m][n]; }
    }
};
struct EpiSsmY {
    static constexpr bool PERM = true;
    bf16_t* Z; int seq, ldz;
    __device__ __forceinline__ void operator()(const f32x4 (&acc)[2][2][4][2], const Unit& u, int wr, int wc, int fr, int fq) const {
        asm volatile("" : "+v"(fr), "+v"(fq));
        const int g = u.pm >> 2, b = u.pm & 3;
        char* zu = (char*)Z + ((size_t)b * seq * ldz + 16 * g) * 2;
        const unsigned loff = (unsigned)((16 * (wr * 64 + fr) + 2 * wc + (fq >> 1)) * ldz + 8 * (fq & 1)) * 2u;
#pragma unroll
        for (int ai = 0; ai < 2; ++ai)
#pragma unroll
            for (int m = 0; m < 4; ++m) {
#pragma unroll
                for (int bj = 0; bj < 2; ++bj) {
                    float r[8];
#pragma unroll
                    for (int n = 0; n < 2; ++n)
#pragma unroll
                        for (int j = 0; j < 4; ++j) { const float y = acc[ai][bj][m][n][j]; r[n * 4 + j] = y * sigmoidf_fast(1.5957691216057308f * y * (1.0f + 0.044715f * y * y)); }
                    u32x4 w; w.x = cvt_pk_bf16(r[0], r[1]); w.y = cvt_pk_bf16(r[2], r[3]); w.z = cvt_pk_bf16(r[4], r[5]); w.w = cvt_pk_bf16(r[6], r[7]);
                    *(u32x4*)(zu + (loff + (unsigned)(((ai * HALF + m * 16) * 16 + 8 * bj) * ldz) * 2u)) = w; } }
    }
};

struct EpiNull {
    static constexpr bool PERM = false;
    __device__ __forceinline__ void operator()(const f32x4 (&acc)[2][2][4][2], const Unit& u, int wr, int wc, int fr, int fq) const {
#pragma unroll
        for (int ai = 0; ai < 2; ++ai)
#pragma unroll
            for (int bj = 0; bj < 2; ++bj)
#pragma unroll
                for (int m = 0; m < 4; ++m)
#pragma unroll
                    for (int n = 0; n < 2; ++n) asm volatile("" :: "v"(acc[ai][bj][m][n]));
    }
};
template <class Epi>
__device__ __forceinline__ void gemm_phase(PG8_LAS unsigned char* lds, const Gemm g, const StaticOrder& S, const Epi& E) {
    const int tid = ptid(), wid = __builtin_amdgcn_readfirstlane(tid >> 6), lane = tid & 63, wr = wid >> 2, wc = wid & 3, fr = lane & 15, fq = lane >> 4;
    const int K = g.K, nt = K / BK;
    unsigned voffA[2], voffB[2];
#pragma unroll
    for (int i = 0; i < 2; ++i) { int R, C; stage_rc(tid * 16 + i * 8192, R, C); const int Rb = Epi::PERM ? ((R & ~31) + perm32(R & 31)) : R;
        voffA[i] = (unsigned)(R * g.lda + C) * 2u; voffB[i] = (unsigned)(Rb * g.ldb + C) * 2u; }
    const long kstep = g.krev ? -(long)(BK * 2) : (long)(BK * 2);
    const long kbase = g.krev ? (long)(nt - 1) * (BK * 2) : 0;
    const size_t hstepA = (size_t)HALF * g.lda * 2, hstepB = (size_t)HALF * g.ldb * 2;
    const size_t tstepA = 2 * hstepA, tstepB = 2 * hstepB;
    const unsigned ldsw = (unsigned)wid * 1024u;
    const int aoff = lds_byte(wr * 64 + fr, fq * 8), boff = lds_byte(wc * 32 + fr, fq * 8);
#define PG8_SA(b, h) (((b) * 2 + (h)) * HTB)
#define PG8_SB(b, h) ((4 + (b) * 2 + (h)) * HTB)
#define PG8_STAGE(bufoff, gbase, voff) do { _Pragma("unroll") for (int _i = 0; _i < 2; ++_i) \
        __builtin_amdgcn_global_load_lds((const unsigned*)((const char*)(gbase) + (voff)[_i]), (PG8_LAS unsigned*)(lds + (bufoff) + ldsw + _i * 8192), 16, 0, 0); } while (0)
#define PG8_LDA(dst, b, h) do { _Pragma("unroll") for (int m = 0; m < 4; ++m) _Pragma("unroll") for (int k = 0; k < 2; ++k) dst[m][k] = *(const PG8_LAS bf16x8*)(lds + PG8_SA(b, h) + aoff + m * 2048 + k * 1024); } while (0)
#define PG8_LDB(dst, b, h) do { _Pragma("unroll") for (int n = 0; n < 2; ++n) _Pragma("unroll") for (int k = 0; k < 2; ++k) dst[n][k] = *(const PG8_LAS bf16x8*)(lds + PG8_SB(b, h) + boff + n * 2048 + k * 1024); } while (0)
#ifndef PG8_PRIO
#define PG8_PRIO 1
#endif
#if PG8_PRIO == 2
#define PG8_MMA(ai, bj, At, Bt) do { _Pragma("unroll") for (int k = 0; k < 2; ++k) { __builtin_amdgcn_s_setprio(1); _Pragma("unroll") for (int m = 0; m < 4; ++m) _Pragma("unroll") for (int n = 0; n < 2; ++n) \
        acc[ai][bj][m][n] = __builtin_amdgcn_mfma_f32_16x16x32_bf16(Bt[n][k], At[m][k], acc[ai][bj][m][n], 0, 0, 0); __builtin_amdgcn_s_setprio(0); __builtin_amdgcn_sched_barrier(0); } } while (0)
#else
#define PG8_MMA(ai, bj, At, Bt) do { if (PG8_PRIO) __builtin_amdgcn_s_setprio(1); _Pragma("unroll") for (int m = 0; m < 4; ++m) _Pragma("unroll") for (int n = 0; n < 2; ++n) _Pragma("unroll") for (int k = 0; k < 2; ++k) \
        acc[ai][bj][m][n] = __builtin_amdgcn_mfma_f32_16x16x32_bf16(Bt[n][k], At[m][k], acc[ai][bj][m][n], 0, 0, 0); if (PG8_PRIO) __builtin_amdgcn_s_setprio(0); } while (0)
#endif
#define PG8_MMA2(ai, At, B0_, B1_) do { __builtin_amdgcn_s_setprio(1); _Pragma("unroll") for (int m = 0; m < 4; ++m) _Pragma("unroll") for (int n = 0; n < 2; ++n) _Pragma("unroll") for (int k = 0; k < 2; ++k) \
        acc[ai][0][m][n] = __builtin_amdgcn_mfma_f32_16x16x32_bf16(B0_[n][k], At[m][k], acc[ai][0][m][n], 0, 0, 0); \
        _Pragma("unroll") for (int m = 0; m < 4; ++m) _Pragma("unroll") for (int n = 0; n < 2; ++n) _Pragma("unroll") for (int k = 0; k < 2; ++k) \
        acc[ai][1][m][n] = __builtin_amdgcn_mfma_f32_16x16x32_bf16(B1_[n][k], At[m][k], acc[ai][1][m][n], 0, 0, 0); __builtin_amdgcn_s_setprio(0); } while (0)
#define PG8_WAIT_V(n) asm volatile("s_waitcnt vmcnt(" #n ")" ::: "memory")
#define PG8_WAIT_L(n) asm volatile("s_waitcnt lgkmcnt(" #n ")" ::: "memory")
#define PG8_BAR __builtin_amdgcn_s_barrier()
#define PG8_SCHED __builtin_amdgcn_sched_barrier(0)
#define PG8_BTILE(u) (g.grp ? (u).pm / g.grp : (u).pn)
    Unit cur, nxt; int ui = 0;
    if (!S.next(0, cur)) return;
    f32x4 acc[2][2][4][2];
#pragma unroll
    for (int a = 0; a < 2; ++a)
#pragma unroll
        for (int b = 0; b < 2; ++b)
#pragma unroll
            for (int m = 0; m < 4; ++m)
#pragma unroll
                for (int n = 0; n < 2; ++n) acc[a][b][m][n] = (f32x4){0.f, 0.f, 0.f, 0.f};
    bf16x8 At[4][2], B0[2][2], B1[2][2];
    const char* cA = (const char*)g.A + (size_t)cur.pm * tstepA + kbase; const char* cB = (const char*)g.Bt + (size_t)PG8_BTILE(cur) * tstepB + kbase;
#if PG8_USE_SP2
    PG8_STAGE(PG8_SB(0, 0), cB, voffB); PG8_STAGE(PG8_SB(0, 1), cB + hstepB, voffB); PG8_STAGE(PG8_SA(0, 0), cA, voffA); PG8_STAGE(PG8_SA(0, 1), cA + hstepA, voffA);
    if (wr == 1) PG8_BAR;
    PG8_WAIT_V(2); PG8_BAR;
#if PG8_DMA_IN_MMA
    PG8_STAGE(PG8_SB(1, 0), cB + kstep, voffB); PG8_STAGE(PG8_SB(1, 1), cB + hstepB + kstep, voffB);
    PG8_WAIT_V(4); PG8_BAR;
#else
    PG8_STAGE(PG8_SB(1, 0), cB + kstep, voffB); PG8_STAGE(PG8_SA(1, 0), cA + kstep, voffA); PG8_STAGE(PG8_SB(1, 1), cB + hstepB + kstep, voffB);
    PG8_WAIT_V(6); PG8_BAR;
#endif
#else
    PG8_STAGE(PG8_SB(0, 0), cB, voffB); PG8_STAGE(PG8_SA(0, 0), cA, voffA); PG8_STAGE(PG8_SB(0, 1), cB + hstepB, voffB); PG8_STAGE(PG8_SA(0, 1), cA + hstepA, voffA);
    if (wr == 1) PG8_BAR;
    PG8_WAIT_V(4); PG8_BAR;
    PG8_STAGE(PG8_SB(1, 0), cB + kstep, voffB); PG8_STAGE(PG8_SA(1, 0), cA + kstep, voffA); PG8_STAGE(PG8_SB(1, 1), cB + hstepB + kstep, voffB);
    PG8_WAIT_V(6); PG8_BAR;
#endif
    for (;;) {
        const bool has_next = S.next(ui + 1, nxt);
        const char* nA = has_next ? (const char*)g.A + (size_t)nxt.pm * tstepA + kbase : cA; const char* nB = has_next ? (const char*)g.Bt + (size_t)PG8_BTILE(nxt) * tstepB + kbase : cB;
#pragma nounroll
        for (int t = 0; t < nt; t += 2) {
            const bool last = (t == nt - 2);
            const char* a1 = cA + (long)(t + 1) * kstep;
            const char* a2 = last ? nA : cA + (long)(t + 2) * kstep; const char* b2 = last ? nB : cB + (long)(t + 2) * kstep;
            const char* a3 = a2 + kstep; const char* b3 = b2 + kstep;
#if PG8_USE_SP2
#if PG8_DMA_IN_MMA
#if PG8_DMA_AFTER_READS
            PG8_LDB(B0, 0, 0); PG8_LDB(B1, 0, 1); PG8_SCHED; PG8_LDA(At, 0, 0); PG8_WAIT_L(0); PG8_SCHED; PG8_STAGE(PG8_SA(1, 0), a1, voffA); PG8_STAGE(PG8_SA(1, 1), a1 + hstepA, voffA);
            PG8_WAIT_V(8); PG8_BAR; PG8_MMA(0, 0, At, B0); PG8_MMA(0, 1, At, B1); PG8_BAR; PG8_SCHED;
            PG8_LDA(At, 0, 1); PG8_WAIT_L(0); PG8_SCHED; PG8_STAGE(PG8_SB(0, 0), b2, voffB); PG8_STAGE(PG8_SB(0, 1), b2 + hstepB, voffB);
            PG8_WAIT_V(4); PG8_BAR; PG8_MMA(1, 0, At, B0); PG8_MMA(1, 1, At, B1); PG8_BAR; PG8_SCHED;
            PG8_LDB(B0, 1, 0); PG8_LDB(B1, 1, 1); PG8_SCHED; PG8_LDA(At, 1, 0); PG8_WAIT_L(0); PG8_SCHED; PG8_STAGE(PG8_SA(0, 0), a2, voffA); PG8_STAGE(PG8_SA(0, 1), a2 + hstepA, voffA);
            PG8_WAIT_V(8); PG8_BAR; PG8_MMA(0, 0, At, B0); PG8_MMA(0, 1, At, B1); PG8_BAR; PG8_SCHED;
            PG8_LDA(At, 1, 1); PG8_WAIT_L(0); PG8_SCHED; PG8_STAGE(PG8_SB(1, 0), b3, voffB); PG8_STAGE(PG8_SB(1, 1), b3 + hstepB, voffB);
            PG8_WAIT_V(4); PG8_BAR; PG8_MMA(1, 0, At, B0); PG8_MMA(1, 1, At, B1); PG8_BAR; PG8_SCHED;
#else
            PG8_LDB(B0, 0, 0); PG8_LDB(B1, 0, 1); PG8_SCHED; PG8_LDA(At, 0, 0); PG8_STAGE(PG8_SA(1, 0), a1, voffA); PG8_STAGE(PG8_SA(1, 1), a1 + hstepA, voffA);
            PG8_WAIT_V(8); PG8_WAIT_L(0); PG8_BAR; PG8_MMA(0, 0, At, B0); PG8_MMA(0, 1, At, B1); PG8_BAR; PG8_SCHED;
            PG8_LDA(At, 0, 1); PG8_STAGE(PG8_SB(0, 0), b2, voffB); PG8_STAGE(PG8_SB(0, 1), b2 + hstepB, voffB);
            PG8_WAIT_V(4); PG8_WAIT_L(0); PG8_BAR; PG8_MMA(1, 0, At, B0); PG8_MMA(1, 1, At, B1); PG8_BAR; PG8_SCHED;
            PG8_LDB(B0, 1, 0); PG8_LDB(B1, 1, 1); PG8_SCHED; PG8_LDA(At, 1, 0); PG8_STAGE(PG8_SA(0, 0), a2, voffA); PG8_STAGE(PG8_SA(0, 1), a2 + hstepA, voffA);
            PG8_WAIT_V(8); PG8_WAIT_L(0); PG8_BAR; PG8_MMA(0, 0, At, B0); PG8_MMA(0, 1, At, B1); PG8_BAR; PG8_SCHED;
            PG8_LDA(At, 1, 1); PG8_STAGE(PG8_SB(1, 0), b3, voffB); PG8_STAGE(PG8_SB(1, 1), b3 + hstepB, voffB);
            PG8_WAIT_V(4); PG8_WAIT_L(0); PG8_BAR; PG8_MMA(1, 0, At, B0); PG8_MMA(1, 1, At, B1); PG8_BAR; PG8_SCHED;
#endif
#else
            PG8_LDB(B0, 0, 0); PG8_LDB(B1, 0, 1); PG8_SCHED; PG8_LDA(At, 0, 0); PG8_STAGE(PG8_SA(1, 1), a1 + hstepA, voffA);
            PG8_WAIT_V(8); PG8_WAIT_L(0); PG8_BAR; PG8_MMA(0, 0, At, B0); PG8_MMA(0, 1, At, B1); PG8_BAR; PG8_SCHED;
            PG8_LDA(At, 0, 1); PG8_STAGE(PG8_SB(0, 0), b2, voffB); PG8_STAGE(PG8_SB(0, 1), b2 + hstepB, voffB); PG8_STAGE(PG8_SA(0, 0), a2, voffA);
            PG8_WAIT_V(8); PG8_WAIT_L(0); PG8_BAR; PG8_MMA(1, 0, At, B0); PG8_MMA(1, 1, At, B1); PG8_BAR; PG8_SCHED;
            PG8_LDB(B0, 1, 0); PG8_LDB(B1, 1, 1); PG8_SCHED; PG8_LDA(At, 1, 0); PG8_STAGE(PG8_SA(0, 1), a2 + hstepA, voffA);
            PG8_WAIT_V(8); PG8_WAIT_L(0); PG8_BAR; PG8_MMA(0, 0, At, B0); PG8_MMA(0, 1, At, B1); PG8_BAR; PG8_SCHED;
            PG8_LDA(At, 1, 1); PG8_STAGE(PG8_SB(1, 0), b3, voffB); PG8_STAGE(PG8_SB(1, 1), b3 + hstepB, voffB); PG8_STAGE(PG8_SA(1, 0), a3, voffA);
            PG8_WAIT_V(8); PG8_WAIT_L(0); PG8_BAR; PG8_MMA(1, 0, At, B0); PG8_MMA(1, 1, At, B1); PG8_BAR; PG8_SCHED;
#endif
#else
            PG8_LDB(B0, 0, 0); PG8_SCHED; PG8_LDA(At, 0, 0); PG8_STAGE(PG8_SA(1, 1), a1 + hstepA, voffA);
            PG8_WAIT_L(8); PG8_BAR; PG8_WAIT_L(0); PG8_MMA(0, 0, At, B0); PG8_BAR; PG8_SCHED;
            PG8_LDB(B1, 0, 1); PG8_STAGE(PG8_SB(0, 0), b2, voffB);
            PG8_BAR; PG8_WAIT_L(0); PG8_MMA(0, 1, At, B1); PG8_BAR;
            PG8_LDA(At, 0, 1); PG8_STAGE(PG8_SA(0, 0), a2, voffA);
            PG8_BAR; PG8_WAIT_L(0); PG8_MMA(1, 0, At, B0); PG8_BAR; PG8_SCHED;
            PG8_STAGE(PG8_SB(0, 1), b2 + hstepB, voffB);
            PG8_WAIT_V(6); PG8_BAR; PG8_MMA(1, 1, At, B1); PG8_BAR;
            PG8_LDB(B0, 1, 0); PG8_SCHED; PG8_LDA(At, 1, 0); PG8_STAGE(PG8_SA(0, 1), a2 + hstepA, voffA);
            PG8_WAIT_L(8); PG8_BAR; PG8_WAIT_L(0); PG8_MMA(0, 0, At, B0); PG8_BAR; PG8_SCHED;
            PG8_LDB(B1, 1, 1); PG8_STAGE(PG8_SB(1, 0), b3, voffB);
            PG8_BAR; PG8_WAIT_L(0); PG8_MMA(0, 1, At, B1); PG8_BAR;
            PG8_LDA(At, 1, 1); PG8_STAGE(PG8_SA(1, 0), a3, voffA);
            PG8_BAR; PG8_WAIT_L(0); PG8_MMA(1, 0, At, B0); PG8_BAR; PG8_SCHED;
            PG8_STAGE(PG8_SB(1, 1), b3 + hstepB, voffB);
            PG8_WAIT_V(6); PG8_BAR; PG8_MMA(1, 1, At, B1); PG8_BAR;
#endif
        }
        if (wr == 0) PG8_BAR;
        E(acc, cur, wr, wc, fr, fq);
        if (!has_next) break;
#pragma unroll
        for (int a = 0; a < 2; ++a)
#pragma unroll
            for (int b = 0; b < 2; ++b)
#pragma unroll
                for (int m = 0; m < 4; ++m)
#pragma unroll
                    for (int n = 0; n < 2; ++n) acc[a][b][m][n] = (f32x4){0.f, 0.f, 0.f, 0.f};
        cur = nxt; cA = nA; cB = nB; ++ui;
        if (wr == 1) PG8_BAR;
    }
    PG8_WAIT_V(0);
    PG8_BAR;
#undef PG8_SA
#undef PG8_SB
#undef PG8_STAGE
#undef PG8_LDA
#undef PG8_LDB
#undef PG8_MMA
#undef PG8_MMA2
#undef PG8_WAIT_V
#undef PG8_WAIT_L
#undef PG8_BAR
#undef PG8_SCHED
#undef PG8_BTILE
}
}
namespace att {
using TIN = __hip_bfloat16; using TOUT = __hip_bfloat16;
constexpr int B = 4, H = 32, HKV = 32, SQ = 4096, SKV = 4096, D = 128;
constexpr int QOFF = 0;
constexpr int WINDOW = SKV;
constexpr float THR = 8.f;
constexpr bool WSKIP = false;
constexpr float SCALE = 0.08838834764831845f;
constexpr int NW = 8, QBLK = 32, KVBLK = 64, QB = NW * QBLK;
constexpr int SHM_V = KVBLK * D * 2, SHM_K = KVBLK * D * 2;
constexpr int LDS_BYTES = 2 * SHM_V + 2 * SHM_K + NW * 64 * 4;
static_assert(D == 128 && SQ % QB == 0 && SKV % KVBLK == 0 && H % HKV == 0 && QOFF >= 0 && QOFF + SQ <= SKV && WINDOW >= 1, "geometry");

using bf16 = __hip_bfloat16;
typedef short bf16x8 __attribute__((ext_vector_type(8)));
typedef short s16x4 __attribute__((ext_vector_type(4)));
typedef float f32x16 __attribute__((ext_vector_type(16)));
typedef float f32x4 __attribute__((ext_vector_type(4)));
typedef unsigned u32x4 __attribute__((ext_vector_type(4)));
template <class A, class Bt> struct same_t { static constexpr bool v = false; };
template <class A> struct same_t<A, A> { static constexpr bool v = true; };

#define KSWZ(row, colB) ((row) * 256 + ((colB) ^ (((row) & 7) << 4)))
#define SBAR() __builtin_amdgcn_sched_barrier(0)
__device__ __forceinline__ int v_st(int k, int c) { const int kk = (k & ~0xC) | ((k & 4) << 1) | ((k & 8) >> 1); return ((kk >> 3) * 4 + (c >> 5)) * 512 + ((kk & 7) * 32 + (c & 31)) * 2; }
__device__ __forceinline__ int v_rd_base(int lane) { return ((lane & 3) << 3) | (((lane >> 2) & 3) << 6) | (((lane >> 4) & 1) << 5) | (((lane >> 5) & 1) << 8); }
constexpr int v_rd_off(int d0, int ks, int half) { return d0 * 512 + ks * 4096 + half * 2048; }
__device__ __forceinline__ int crow(int r, int hi) { return (r & 3) + 8 * (r >> 2) + 4 * hi; }
__device__ __forceinline__ unsigned cvtpk(float lo, float hi) {
    unsigned r; asm volatile("v_cvt_pk_bf16_f32 %0, %1, %2" : "=v"(r) : "v"(lo), "v"(hi)); return r;
}
__device__ __forceinline__ bf16x8 pack8(f32x4 a, f32x4 b) {
    u32x4 w = {cvtpk(a[0], a[1]), cvtpk(a[2], a[3]), cvtpk(b[0], b[1]), cvtpk(b[2], b[3])};
    return *reinterpret_cast<bf16x8*>(&w);
}
template <class T> __device__ __forceinline__ bf16x8 load8(const T* p) {
    if constexpr (same_t<T, float>::v) { return pack8(*(const f32x4*)p, *(const f32x4*)(p + 4)); }
    else { return *reinterpret_cast<const bf16x8*>(p); }
}
__device__ __forceinline__ void mask_tile(f32x16& p0, f32x16& p1, int dq, unsigned W) {
    const float NEG = -__builtin_inff();
#pragma unroll
    for (int r = 0; r < 16; ++r) {
        const int c = (r & 3) + 8 * (r >> 2);
        if ((unsigned)(dq - c) >= W) p0[r] = NEG;
        if ((unsigned)(dq - c - 32) >= W) p1[r] = NEG;
    }
}
__device__ __forceinline__ void partialSM(f32x16& p0, f32x16& p1, float& m_reg, float& mn, float& alpha) {
    float pmax = p0[0]; for (int r = 1; r < 16; ++r) pmax = fmaxf(pmax, p0[r]); for (int r = 0; r < 16; ++r) pmax = fmaxf(pmax, p1[r]);
    { auto rr = __builtin_amdgcn_permlane32_swap(__float_as_uint(pmax), __float_as_uint(pmax), false, false);
      pmax = fmaxf(__uint_as_float(rr[0]), __uint_as_float(rr[1])); }
    constexpr float C2 = 1.4426950408889634f * SCALE;
    if (__builtin_expect(__all((pmax - m_reg) * SCALE <= THR), 1)) { mn = m_reg; alpha = 1.f; }
    else { mn = fmaxf(m_reg, pmax); alpha = __builtin_amdgcn_exp2f((m_reg - mn) * C2); m_reg = mn; }
    const float mnL = -mn * C2;
    for (int r = 0; r < 16; ++r) p0[r] = fmaf(p0[r], C2, mnL); for (int r = 0; r < 16; ++r) p1[r] = fmaf(p1[r], C2, mnL);
    for (int r = 0; r < 16; ++r) p0[r] = __builtin_amdgcn_exp2f(p0[r]);
}
__device__ __forceinline__ void finishSM(f32x16& p0, f32x16& p1, float alpha, float& l_reg, bf16x8& pa0, bf16x8& pa1, bf16x8& pa2, bf16x8& pa3) {
    for (int r = 0; r < 16; ++r) p1[r] = __builtin_amdgcn_exp2f(p1[r]);
    float ps = 0; for (int r = 0; r < 16; ++r) ps += p0[r]; for (int r = 0; r < 16; ++r) ps += p1[r];
    { auto rr = __builtin_amdgcn_permlane32_swap(__float_as_uint(ps), __float_as_uint(ps), false, false);
      ps = __uint_as_float(rr[0]) + __uint_as_float(rr[1]); }
    l_reg = l_reg * alpha + ps;
#define PK4(P, B_, OUT) do { unsigned a0 = cvtpk(P[B_+0], P[B_+1]), a1 = cvtpk(P[B_+2], P[B_+3]);                          \
        unsigned b0 = cvtpk(P[B_+4], P[B_+5]), b1 = cvtpk(P[B_+6], P[B_+7]);                                             \
        auto r0 = __builtin_amdgcn_permlane32_swap(a0, b0, false, false); auto r1 = __builtin_amdgcn_permlane32_swap(a1, b1, false, false); \
        u32x4 w = {r0[0], r1[0], r0[1], r1[1]}; OUT = *reinterpret_cast<bf16x8*>(&w); } while (0)
    PK4(p0, 0, pa0); PK4(p0, 8, pa1); PK4(p1, 0, pa2); PK4(p1, 8, pa3);
#undef PK4
}
template <int KB, bool SK>
__device__ __forceinline__ void qkt(f32x16& p0, f32x16& p1, const char* K_lds, int r32, int hi, const bf16x8* qr, bool act) {
    if (SK && !act) { const float NEG = -__builtin_inff();
#pragma unroll
        for (int r = 0; r < 16; ++r) { p0[r] = NEG; p1[r] = NEG; } return; }
    p0 = f32x16{}; p1 = f32x16{};
    const char* kb[4];
#pragma unroll
    for (int dd = 0; dd < 4; ++dd) kb[dd] = K_lds + KB * SHM_K + KSWZ(r32, (dd * 16 + hi * 8) * 2);
#pragma unroll
    for (int d0 = 0; d0 < 8; ++d0) { const char* a = kb[d0 & 3] + (d0 >> 2) * 128;
        bf16x8 b0 = *reinterpret_cast<const bf16x8*>(a);
        bf16x8 b1 = *reinterpret_cast<const bf16x8*>(a + 32 * 256);
        p0 = __builtin_amdgcn_mfma_f32_32x32x16_bf16(b0, qr[d0], p0, 0, 0, 0);
        p1 = __builtin_amdgcn_mfma_f32_32x32x16_bf16(b1, qr[d0], p1, 0, 0, 0); }
}
template <int VB, bool SK>
__device__ __forceinline__ void pv_tile(f32x16* o, int vb0, bf16x8 pa0, bf16x8 pa1, bf16x8 pa2, bf16x8 pa3, bool act) {
    if (SK && !act) return;
#define TRRD(dst, off) asm volatile("ds_read_b64_tr_b16 %0, %1 offset:%2" : "=&v"(dst) : "v"(vb0), "i"(off) : "memory")
#define PV_D0(d0) do { s16x4 l0, l1, l2, l3, h0, h1, h2, h3; constexpr int b_ = VB * SHM_V + v_rd_off(d0, 0, 0);     \
        TRRD(l0, b_); TRRD(h0, b_ + 2048); TRRD(l1, b_ + 4096); TRRD(h1, b_ + 6144); TRRD(l2, b_ + 8192); TRRD(h2, b_ + 10240); TRRD(l3, b_ + 12288); TRRD(h3, b_ + 14336); \
        asm volatile("s_waitcnt lgkmcnt(0)" ::: "memory"); SBAR();                 \
        o[d0] = __builtin_amdgcn_mfma_f32_32x32x16_bf16(pa0, (bf16x8){l0[0], l0[1], l0[2], l0[3], h0[0], h0[1], h0[2], h0[3]}, o[d0], 0, 0, 0);   \
        o[d0] = __builtin_amdgcn_mfma_f32_32x32x16_bf16(pa1, (bf16x8){l1[0], l1[1], l1[2], l1[3], h1[0], h1[1], h1[2], h1[3]}, o[d0], 0, 0, 0);   \
        o[d0] = __builtin_amdgcn_mfma_f32_32x32x16_bf16(pa2, (bf16x8){l2[0], l2[1], l2[2], l2[3], h2[0], h2[1], h2[2], h2[3]}, o[d0], 0, 0, 0);   \
        o[d0] = __builtin_amdgcn_mfma_f32_32x32x16_bf16(pa3, (bf16x8){l3[0], l3[1], l3[2], l3[3], h3[0], h3[1], h3[2], h3[3]}, o[d0], 0, 0, 0); } while (0)
    PV_D0(0); PV_D0(1); PV_D0(2); PV_D0(3);
#undef PV_D0
#undef TRRD
}

template <class TIn, class TOut> struct BlockRef { const TIn* Q; const TIn* K; const TIn* V; TOut* O; int P0; };
template <class TIn> struct Seam {
    bf16x8 qr[8];
    bf16x8 st_v0, st_v1, st_k0, st_k1; f32x4 sf0, sf1, sf2, sf3;
    f32x4 tq[16];
};
__device__ __forceinline__ int swa_jlo(int P0, int W) { const int lowk = P0 - W + 1; return lowk > 0 ? lowk / KVBLK : 0; }
#define ROW(p, k0, rr) ((p) + (size_t)((k0) + (rr)) * D + sc)
#define VMW() asm volatile("s_waitcnt vmcnt(0)" ::: "memory")
#define VMWN(n) asm volatile("s_waitcnt vmcnt(%0)" :: "i"(n) : "memory")
#define SLOAD_H(Kp, Vp, k0) do { S.st_v0 = load8<TIn>(ROW(Vp, k0, sr)); S.st_v1 = load8<TIn>(ROW(Vp, k0, 32 + sr));              \
                         S.st_k0 = load8<TIn>(ROW(Kp, k0, sr)); S.st_k1 = load8<TIn>(ROW(Kp, k0, 32 + sr)); } while (0)
#define SWRITE_HK(bf) do { *(bf16x8*)(K_lds + (bf) * SHM_K + kws) = S.st_k0; *(bf16x8*)(K_lds + (bf) * SHM_K + kws + 32 * 256) = S.st_k1; } while (0)
#define SWRITE_HV(bf) do { *(bf16x8*)(V_lds + (bf) * SHM_V + vst0) = S.st_v0; *(bf16x8*)(V_lds + (bf) * SHM_V + vst1) = S.st_v1; } while (0)
#define SWRITE_H(bf) do { SWRITE_HV(bf); SWRITE_HK(bf); } while (0)
#define SLOAD_F(p, k0) do { S.sf0 = *(const f32x4*)ROW(p, k0, sr); S.sf1 = *(const f32x4*)(ROW(p, k0, sr) + 4);                \
                            S.sf2 = *(const f32x4*)ROW(p, k0, 32 + sr); S.sf3 = *(const f32x4*)(ROW(p, k0, 32 + sr) + 4); } while (0)
#define SWRITE_KF(bf) do { *(bf16x8*)(K_lds + (bf) * SHM_K + kws) = pack8(S.sf0, S.sf1); *(bf16x8*)(K_lds + (bf) * SHM_K + kws + 32 * 256) = pack8(S.sf2, S.sf3); } while (0)
#define SWRITE_VF(bf) do { *(bf16x8*)(V_lds + (bf) * SHM_V + vst0) = pack8(S.sf0, S.sf1); *(bf16x8*)(V_lds + (bf) * SHM_V + vst1) = pack8(S.sf2, S.sf3); } while (0)
template <class TIn, class TOut>
__device__ __forceinline__ void causal_swa_prime(const BlockRef<TIn, TOut>& cur, int W, char* lds, Seam<TIn>& S) {
    constexpr bool F32 = same_t<TIn, float>::v;
    const int tid = ptid(), wid = __builtin_amdgcn_readfirstlane(tid >> 6), lane = tid & 63, r32 = lane & 31, hi = lane >> 5;
    const int sr = tid >> 4, sc = (tid & 15) * 8, kws = KSWZ(sr, sc * 2); char* K_lds = lds + 2 * SHM_V;
    const int kb0 = swa_jlo(cur.P0, W) * KVBLK;
    for (int d0 = 0; d0 < 8; ++d0) S.qr[d0] = load8<TIn>(cur.Q + (size_t)(wid * QBLK + r32) * D + d0 * 16 + hi * 8);
    if constexpr (F32) { SLOAD_F((const float*)cur.K, kb0); VMW(); SWRITE_KF(0); SBAR(); SLOAD_F((const float*)cur.V, kb0); }
    else { SLOAD_H(cur.K, cur.V, kb0); VMW(); SWRITE_HK(0); }
    __syncthreads();
}
template <class TIn, class TOut>
__device__ __forceinline__ void causal_swa_block(const BlockRef<TIn, TOut>& cur, const BlockRef<TIn, TOut>& nxt, int skv, int W, char* lds, Seam<TIn>& S) {
    constexpr bool F32 = same_t<TIn, float>::v;
    const int tid = ptid(), wid = __builtin_amdgcn_readfirstlane(tid >> 6), lane = tid & 63, r32 = lane & 31, hi = lane >> 5;
    const int j_lo = swa_jlo(cur.P0, W);
    int j_hi = (cur.P0 + QB - 1) / KVBLK + 1; if (j_hi > skv / KVBLK) j_hi = skv / KVBLK;
    const int NT = j_hi - j_lo;
    const int kbn = swa_jlo(nxt.P0, W) * KVBLK;
    const int qlo = cur.P0 + wid * QBLK, qm = qlo + r32 - 4 * hi;
    char* V_lds = lds; char* K_lds = lds + 2 * SHM_V;
    float* ws = (float*)(lds + 2 * SHM_V + 2 * SHM_K) + wid * 64; float* li_l = ws, * al_l = ws + 32;
    float m_reg = -1e30f, l_reg = 0; f32x16 o[4] = {};
    const int sr = tid >> 4, sc = (tid & 15) * 8, vst0 = v_st(sr, sc), vst1 = v_st(32 + sr, sc), kws = KSWZ(sr, sc * 2);
    const int vb0 = (int)(uintptr_t)V_lds + v_rd_base(lane);
    const TIn* Kh = cur.K; const TIn* Vh = cur.V;
#define RESC(a) do { if (__any((a) < 1.f)) { if (hi == 0) al_l[r32] = (a); asm volatile("s_waitcnt lgkmcnt(0)" ::: "memory");              \
                     for (int d_ = 0; d_ < 4; ++d_) for (int r = 0; r < 16; ++r) o[d_][r] *= al_l[crow(r, hi)]; } } while (0)
#define KBASE(t) ((j_lo + (t)) * KVBLK)
#define ACT(t) (KBASE(t) <= qlo + QBLK - 1 && KBASE(t) + KVBLK - 1 >= qlo - W + 1)
#define MASKT(P0_, P1_, t) do { const int kb_ = KBASE(t); if ((!SK || ACT(t)) && (kb_ + KVBLK - 1 > qlo || kb_ <= qlo + QBLK - 1 - W)) mask_tile(P0_, P1_, qm - kb_, (unsigned)W); } while (0)
    constexpr int NQL = F32 ? 16 : 8;
    constexpr bool SK = WSKIP && !F32;
#define SEAM_K0() do { VMWN(NQL); if constexpr (F32) { SWRITE_KF(0); SBAR(); SLOAD_F((const float*)nxt.V, kbn); } else { SWRITE_HK(0); } SBAR(); } while (0)
    f32x16 pA0, pA1, pB0, pB1; float mnA, mnB, alA, alB; bf16x8 pa0, pa1, pa2, pa3;
    if constexpr (F32) { VMW(); SWRITE_VF(0); SBAR(); } else { SWRITE_HV(0); SBAR(); }
    if (NT > 1) { if constexpr (F32) SLOAD_F((const float*)Kh, KBASE(1)); else SLOAD_H(Kh, Vh, KBASE(1)); }
    SBAR(); qkt<0, SK>(pA0, pA1, K_lds, r32, hi, S.qr, ACT(0));
    if constexpr (F32) { if (NT > 1) { VMW(); SWRITE_KF(1); SBAR(); SLOAD_F((const float*)Vh, KBASE(1)); } }
    MASKT(pA0, pA1, 0); partialSM(pA0, pA1, m_reg, mnA, alA);
    if (NT > 1) { VMW(); if constexpr (F32) { SWRITE_VF(1); SBAR(); if (NT > 2) SLOAD_F((const float*)Kh, KBASE(2)); } else SWRITE_H(1); }
    __syncthreads();
#define HALF_STEP(PX0, PX1, mnX, alX, PY0, PY1, alY, t, KB, VB, SB) do {                                                      \
        SBAR(); qkt<KB, SK>(PX0, PX1, K_lds, r32, hi, S.qr, ACT(t));                                             \
        finishSM(PY0, PY1, alY, l_reg, pa0, pa1, pa2, pa3); SBAR();                                                           \
        if ((t) + 1 < NT) { if constexpr (F32) { VMW(); SWRITE_KF(SB); SBAR(); SLOAD_F((const float*)Vh, KBASE((t) + 1)); }  \
                            else { SLOAD_H(Kh, Vh, KBASE((t) + 1)); } SBAR(); }                                               \
        pv_tile<VB, SK>(o, vb0, pa0, pa1, pa2, pa3, ACT((t) - 1)); MASKT(PX0, PX1, (t)); partialSM(PX0, PX1, m_reg, mnX, alX);                                        \
        __syncthreads();                                                                                                      \
        if ((t) + 1 < NT) { VMW(); if constexpr (F32) { SWRITE_VF(SB); SBAR(); if ((t) + 2 < NT) SLOAD_F((const float*)Kh, KBASE((t) + 2)); } \
                            else { SWRITE_H(SB); } }                                                                          \
        RESC(alX); __syncthreads(); } while (0)
    for (int t = 1; t + 1 < NT; t += 2) {
        HALF_STEP(pB0, pB1, mnB, alB, pA0, pA1, alA, t, 1, 0, 0);
        HALF_STEP(pA0, pA1, mnA, alA, pB0, pB1, alB, t + 1, 0, 1, 1);
    }
    const bool even = (NT & 1) == 0;
    if (even) { SBAR(); qkt<1, SK>(pB0, pB1, K_lds, r32, hi, S.qr, ACT(NT - 1)); SBAR(); }
#define QROW(e) (nxt.Q + (size_t)(wid * QBLK + r32) * D + ((e) >> 1) * 16 + hi * 8 + ((e) & 1) * 4)
    if constexpr (F32) { SLOAD_F((const float*)nxt.K, kbn); SBAR();
#pragma unroll
        for (int e = 0; e < 8; ++e) S.tq[e] = *(const f32x4*)QROW(e); }
    else { SLOAD_H(nxt.K, nxt.V, kbn); SBAR();
#pragma unroll
        for (int d0 = 0; d0 < 8; ++d0) S.qr[d0] = load8<TIn>(nxt.Q + (size_t)(wid * QBLK + r32) * D + d0 * 16 + hi * 8); }
    SBAR();
    finishSM(pA0, pA1, alA, l_reg, pa0, pa1, pa2, pa3); SBAR();
    if constexpr (F32) {
#pragma unroll
        for (int e = 8; e < 16; ++e) S.tq[e] = *(const f32x4*)QROW(e); SBAR(); }
#undef QROW
    pv_tile<0, SK>(o, vb0, pa0, pa1, pa2, pa3, ACT(even ? NT - 2 : NT - 1));
    if (even) { MASKT(pB0, pB1, NT - 1); partialSM(pB0, pB1, m_reg, mnB, alB); __syncthreads(); RESC(alB);
        finishSM(pB0, pB1, alB, l_reg, pa0, pa1, pa2, pa3); SBAR(); pv_tile<1, SK>(o, vb0, pa0, pa1, pa2, pa3, ACT(NT - 1)); }
    SBAR(); SEAM_K0();
    if (hi == 0) li_l[r32] = l_reg; asm volatile("s_waitcnt lgkmcnt(0)" ::: "memory");
    float rli[16];
#pragma unroll
    for (int r = 0; r < 16; ++r) rli[r] = __builtin_amdgcn_rcpf(li_l[crow(r, hi)]);
    TOut* Ow = cur.O + (size_t)(wid * QBLK) * D;
#pragma unroll
    for (int r = 0; r < 16; ++r) { const int orow = crow(r, hi);
#pragma unroll
        for (int d0 = 0; d0 < 4; ++d0) { const float v = o[d0][r] * rli[r];
            if constexpr (same_t<TOut, float>::v) { Ow[(size_t)orow * D + d0 * 32 + r32] = v; }
            else { const float vn = __shfl_xor(v, 1);
                   if ((r32 & 1) == 0) *(unsigned*)(Ow + (size_t)orow * D + d0 * 32 + r32) = cvtpk(v, vn); } } }
    if constexpr (F32) {
#pragma unroll
        for (int d0 = 0; d0 < 8; ++d0) S.qr[d0] = pack8(S.tq[2 * d0], S.tq[2 * d0 + 1]); }
    __syncthreads();
#undef RESC
#undef KBASE
#undef ACT
#undef MASKT
#undef SEAM_K0
#undef HALF_STEP
}
#undef ROW
#undef VMW
#undef VMWN
#undef SLOAD_H
#undef SWRITE_HK
#undef SWRITE_HV
#undef SWRITE_H
#undef SLOAD_F
#undef SWRITE_KF
#undef SWRITE_VF
}
namespace att {
#define SKA_LAS __attribute__((address_space(3)))
constexpr int SKA_STATS = 148480;
struct SkaRef { const bf16* Q; const bf16* K; const bf16* V0; const bf16* V1; bf16* O; int P0; int pm; };
constexpr float SKA_C2 = 1.4426950408889634f * SCALE;
__device__ __forceinline__ void ska_sm_a(f32x16& s, float& m_reg, float& mn, float& alpha) {
    float pmax = s[0];
#pragma unroll
    for (int r = 1; r < 16; ++r) pmax = fmaxf(pmax, s[r]);
    { auto rr = __builtin_amdgcn_permlane32_swap(__float_as_uint(pmax), __float_as_uint(pmax), false, false);
      pmax = fmaxf(__uint_as_float(rr[0]), __uint_as_float(rr[1])); }
    if (__builtin_expect(__all((pmax - m_reg) * SCALE <= THR), 1)) { mn = m_reg; alpha = 1.f; }
    else { mn = fmaxf(m_reg, pmax); alpha = __builtin_amdgcn_exp2f((m_reg - mn) * SKA_C2); m_reg = mn; }
    const float mnL = -mn * SKA_C2;
#pragma unroll
    for (int r = 0; r < 16; ++r) s[r] = fmaf(s[r], SKA_C2, mnL);
#pragma unroll
    for (int r = 0; r < 8; ++r) s[r] = __builtin_amdgcn_exp2f(s[r]);
}
__device__ __forceinline__ void ska_sm_b(f32x16& s, float alpha, float& l_reg, bf16x8& pa0, bf16x8& pa1) {
#pragma unroll
    for (int r = 8; r < 16; ++r) s[r] = __builtin_amdgcn_exp2f(s[r]);
    float ps = 0;
#pragma unroll
    for (int r = 0; r < 16; ++r) ps += s[r];
    { auto rr = __builtin_amdgcn_permlane32_swap(__float_as_uint(ps), __float_as_uint(ps), false, false);
      ps = __uint_as_float(rr[0]) + __uint_as_float(rr[1]); }
    l_reg = l_reg * alpha + ps;
#define PK4(P, B_, OUT) do { unsigned a0 = cvtpk(P[B_+0], P[B_+1]), a1 = cvtpk(P[B_+2], P[B_+3]);                          \
        unsigned b0 = cvtpk(P[B_+4], P[B_+5]), b1 = cvtpk(P[B_+6], P[B_+7]);                                             \
        auto r0 = __builtin_amdgcn_permlane32_swap(a0, b0, false, false); auto r1 = __builtin_amdgcn_permlane32_swap(a1, b1, false, false); \
        u32x4 w = {r0[0], r1[0], r0[1], r1[1]}; OUT = *reinterpret_cast<bf16x8*>(&w); } while (0)
    PK4(s, 0, pa0); PK4(s, 8, pa1);
#undef PK4
}
__device__ __forceinline__ void ska_mask(f32x16& s, int dq) {
    const float NEG = -__builtin_inff();
#pragma unroll
    for (int r = 0; r < 16; ++r) { const int c = (r & 3) + 8 * (r >> 2); if (dq - c < 0) s[r] = NEG; }
}
__device__ __forceinline__ void ska_pv(f32x16* o, int vb, bf16x8 pa0, bf16x8 pa1) {
#define TRRD(dst, off) asm volatile("ds_read_b64_tr_b16 %0, %1 offset:%2" : "=&v"(dst) : "v"(vb), "i"(off) : "memory")
#define SKA_RD(F, blk) do { constexpr int b_ = ((blk) >> 2) * 16384 + ((blk) & 3) * 512; TRRD(F[0], b_); TRRD(F[1], b_ + 2048); TRRD(F[2], b_ + 4096); TRRD(F[3], b_ + 6144); } while (0)
#define SKA_MM(F, blk) do { \
        o[blk] = __builtin_amdgcn_mfma_f32_32x32x16_bf16(pa0, (bf16x8){F[0][0], F[0][1], F[0][2], F[0][3], F[1][0], F[1][1], F[1][2], F[1][3]}, o[blk], 0, 0, 0); \
        o[blk] = __builtin_amdgcn_mfma_f32_32x32x16_bf16(pa1, (bf16x8){F[2][0], F[2][1], F[2][2], F[2][3], F[3][0], F[3][1], F[3][2], F[3][3]}, o[blk], 0, 0, 0); } while (0)
#define SKA_W4() do { asm volatile("s_waitcnt lgkmcnt(4)" ::: "memory"); SBAR(); } while (0)
#define SKA_W0() do { asm volatile("s_waitcnt lgkmcnt(0)" ::: "memory"); SBAR(); } while (0)
    s16x4 fa[4], fb[4];
    SBAR();
    SKA_RD(fa, 0);
    SKA_RD(fb, 1); SKA_W4(); SKA_MM(fa, 0); SBAR();
    SKA_RD(fa, 2); SKA_W4(); SKA_MM(fb, 1); SBAR();
    SKA_RD(fb, 3); SKA_W4(); SKA_MM(fa, 2); SBAR();
    SKA_RD(fa, 4); SKA_W4(); SKA_MM(fb, 3); SBAR();
    SKA_RD(fb, 5); SKA_W4(); SKA_MM(fa, 4); SBAR();
    SKA_RD(fa, 6); SKA_W4(); SKA_MM(fb, 5); SBAR();
    SKA_RD(fb, 7); SKA_W4(); SKA_MM(fa, 6); SBAR();
    SKA_W0(); SKA_MM(fb, 7); SBAR();
#undef SKA_W0
#undef SKA_W4
#undef SKA_MM
#undef SKA_RD
#undef TRRD
}
template <int KH>
__device__ __forceinline__ void ska_merge(f32x16* o, const SkaRef& R, char* lds, int wid, int lane, int rg, const float* fr) {
    constexpr int KEEP = KH * 4, SEND = (1 - KH) * 4;
    const int r32 = lane & 31, hi = lane >> 5;
    f32x4* xs = reinterpret_cast<f32x4*>(lds + wid * 16384) + lane;
#pragma unroll
    for (int d = 0; d < 4; ++d)
#pragma unroll
        for (int q = 0; q < 4; ++q) { f32x4 v = {o[SEND + d][4 * q] * fr[4 * q], o[SEND + d][4 * q + 1] * fr[4 * q + 1], o[SEND + d][4 * q + 2] * fr[4 * q + 2], o[SEND + d][4 * q + 3] * fr[4 * q + 3]};
            xs[(d * 4 + q) * 64] = v; }
    __syncthreads();
    const f32x4* xr = reinterpret_cast<const f32x4*>(lds + (wid ^ 4) * 16384) + lane;
    bf16* Ow = R.O + (size_t)(rg * 32) * 256 + KEEP * 32 + r32;
#pragma unroll
    for (int d = 0; d < 4; ++d)
#pragma unroll
        for (int q = 0; q < 4; ++q) { const f32x4 p = xr[(d * 4 + q) * 64];
#pragma unroll
            for (int j = 0; j < 4; ++j) { const int r = 4 * q + j; const float v = o[KEEP + d][r] * fr[r] + p[j];
                const float vn = __shfl_xor(v, 1);
                if ((r32 & 1) == 0) *(unsigned*)(Ow + (size_t)crow(r, hi) * 256 + d * 32) = cvtpk(v, vn); } }
}
__device__ __forceinline__ void ska_block(const SkaRef& R, char* lds, SKA_LAS unsigned char* ldsl) {
    const int tid = ptid(), wid = __builtin_amdgcn_readfirstlane(tid >> 6), lane = tid & 63, r32 = lane & 31, hi = lane >> 5;
    const int rg = wid & 3, kh = wid >> 2, pm = R.pm;
    const int NT = (R.P0 + 127) / KVBLK + 1;
    const int qlo = R.P0 + rg * 32, qm = qlo + r32 - 4 * hi - 32 * kh;
    const char* gK; const char* gV0; const char* gV1;
    { const int row = tid >> 4, cp = tid & 15; gK = (const char*)R.K + row * 256 + ((cp ^ (row & 7)) << 4);
      const int sub = tid >> 5, kk = (sub >> 2) * 8 + ((tid >> 2) & 7), k = (kk & ~0xC) | ((kk & 4) << 1) | ((kk & 8) >> 1), c = (sub & 3) * 32 + (tid & 3) * 8;
      gV0 = (const char*)R.V0 + k * 256 + c * 2; gV1 = (const char*)R.V1 + k * 256 + c * 2; }
    const unsigned ldsw = (unsigned)wid * 1024u;
#define SKA_G(g, l) __builtin_amdgcn_global_load_lds((const unsigned*)(g), (SKA_LAS unsigned*)(ldsl + (l)), 16, 0, 0)
#define SKA_DMAK(T_, KS_) do { if (pm == 3) break; const size_t go_ = pm == 1 ? 0 : (size_t)(T_) * (KVBLK * 256); const unsigned kd_ = (unsigned)(KS_) * 16384u + ldsw; SKA_G(gK + go_, kd_); SKA_G(gK + go_ + 8192, kd_ + 8192); } while (0)
#define SKA_DMAV(T_, VS_) do { if (pm == 3) break; const size_t go_ = pm == 1 ? 0 : (size_t)(T_) * (KVBLK * 256); const unsigned vd_ = 49152u + (unsigned)(VS_) * 32768u + ldsw; \
        SKA_G(gV0 + go_, vd_); SKA_G(gV0 + go_ + 8192, vd_ + 8192); SKA_G(gV1 + go_, vd_ + 16384); SKA_G(gV1 + go_ + 8192, vd_ + 24576); } while (0)
    char* Kl = lds; float* st = (float*)(lds + SKA_STATS) + wid * 128;
    int kofs[4];
#pragma unroll
    for (int dd = 0; dd < 4; ++dd) kofs[dd] = KSWZ(r32 + 32 * kh, (dd * 16 + hi * 8) * 2);
    const int vb0 = (int)(uintptr_t)(lds + 49152) + v_rd_base(lane) + kh * 8192;
#define SKA_QK(S_, KS_) do { S_ = f32x16{}; const char* kp_ = Kl + (KS_) * 16384; _Pragma("unroll") for (int d0 = 0; d0 < 8; ++d0) { \
        const bf16x8 b_ = *reinterpret_cast<const bf16x8*>(kp_ + kofs[d0 & 3] + (d0 >> 2) * 128); S_ = __builtin_amdgcn_mfma_f32_32x32x16_bf16(b_, qr[d0], S_, 0, 0, 0); } } while (0)
#define SKA_MASK(S_, T_) do { const int kb_ = (T_) * KVBLK; if (kb_ + 32 * kh + 31 > qlo) ska_mask(S_, qm - kb_); } while (0)
#define SKA_RESC(a) do { if (__any((a) < 1.f)) { if (hi == 0) st[r32] = (a); asm volatile("s_waitcnt lgkmcnt(0)" ::: "memory");              \
        _Pragma("unroll") for (int d_ = 0; d_ < 8; ++d_) _Pragma("unroll") for (int r = 0; r < 16; ++r) o[d_][r] *= st[crow(r, hi)]; } } while (0)
    SKA_DMAK(0, 0); SKA_DMAV(0, 0); if (NT > 1) SKA_DMAK(1, 1);
    bf16x8 qr[8];
#pragma unroll
    for (int d0 = 0; d0 < 8; ++d0) qr[d0] = *reinterpret_cast<const bf16x8*>(R.Q + (size_t)(rg * 32 + r32) * D + d0 * 16 + hi * 8);
    float m_reg = -1e30f, l_reg = 0; f32x16 o[8] = {};
    f32x16 sA, sB; float mnA, mnB, alA, alB; bf16x8 pa0, pa1;
    asm volatile("s_waitcnt vmcnt(0)" ::: "memory"); __syncthreads();
    if (NT > 2) SKA_DMAK(2, 2);
    if (NT > 1) SKA_DMAV(1, 1);
    SBAR(); SKA_QK(sA, 0); SKA_MASK(sA, 0); ska_sm_a(sA, m_reg, mnA, alA);
    __syncthreads();
    int kr = 1, kw = 0, vr = 0, vw = 2;
#define SKA_STEP(SX, mnX, alX, SY, alY, T_) do { const int t_ = (T_);                                                          \
        if (t_ + 2 < NT) SKA_DMAK(t_ + 2, kw);                                                                                 \
        if (t_ + 1 < NT) SKA_DMAV(t_ + 1, vw);                                                                                 \
        SBAR(); SKA_QK(SX, kr);                                                                                                \
        if (pm != 4) ska_sm_b(SY, alY, l_reg, pa0, pa1); else { pa0 = (bf16x8){(short)SY[0], 1, 2, 3, 4, 5, 6, 7}; pa1 = pa0; } SBAR();    \
        if (pm != 5) ska_pv(o, vb0 + vr * 32768, pa0, pa1); SKA_MASK(SX, t_); if (pm != 4) ska_sm_a(SX, m_reg, mnX, alX); else alX = 1.f;   \
        SKA_RESC(alX);                                                                                                         \
        if (t_ + 2 < NT) asm volatile("s_waitcnt vmcnt(6)" ::: "memory"); else if (t_ + 1 < NT) asm volatile("s_waitcnt vmcnt(4)" ::: "memory"); else asm volatile("s_waitcnt vmcnt(0)" ::: "memory"); \
        if (pm != 2) __syncthreads();                                                                                          \
        kr = kr == 2 ? 0 : kr + 1; kw = kw == 2 ? 0 : kw + 1; vr = vr == 2 ? 0 : vr + 1; vw = vw == 2 ? 0 : vw + 1; } while (0)
#pragma nounroll
    for (int t = 1; t < NT; ++t) { SKA_STEP(sB, mnB, alB, sA, alA, t); sA = sB; alA = alB; }
    ska_sm_b(sA, alA, l_reg, pa0, pa1); SBAR(); ska_pv(o, vb0 + vr * 32768, pa0, pa1);
    if (hi == 0) { st[32 + r32] = m_reg; st[64 + r32] = l_reg; }
    __syncthreads();
    { const float* sp = (const float*)(lds + SKA_STATS) + (wid ^ 4) * 128;
      const float mp = sp[32 + r32], lp = sp[64 + r32], m = fmaxf(m_reg, mp);
      const float wsf = __builtin_amdgcn_exp2f((m_reg - m) * SKA_C2), wpf = __builtin_amdgcn_exp2f((mp - m) * SKA_C2);
      const float f = wsf * __builtin_amdgcn_rcpf(l_reg * wsf + lp * wpf);
      if (hi == 0) st[r32] = f; asm volatile("s_waitcnt lgkmcnt(0)" ::: "memory"); }
    float fr[16];
#pragma unroll
    for (int r = 0; r < 16; ++r) fr[r] = st[crow(r, hi)];
    if (kh == 0) ska_merge<0>(o, R, lds, wid, lane, rg, fr); else ska_merge<1>(o, R, lds, wid, lane, rg, fr);
    __syncthreads();
#undef SKA_STEP
#undef SKA_RESC
#undef SKA_MASK
#undef SKA_QK
#undef SKA_DMAK
#undef SKA_DMAV
#undef SKA_G
}
}
namespace att {
constexpr int WVA_STATS = 148480;
__device__ __forceinline__ void wva_pv(f32x16* o, int vb, bf16x8 pa0, bf16x8 pa1, bf16x8 pa2, bf16x8 pa3) {
#define TRRD(dst, off) asm volatile("ds_read_b64_tr_b16 %0, %1 offset:%2" : "=&v"(dst) : "v"(vb), "i"(off) : "memory")
#define WVA_RD(F, j) do { constexpr int b_ = (((j) >> 1) >> 2) * 16384 + (((j) >> 1) & 3) * 512 + ((j) & 1) * 8192; TRRD(F[0], b_); TRRD(F[1], b_ + 2048); TRRD(F[2], b_ + 4096); TRRD(F[3], b_ + 6144); } while (0)
#define WVA_MM(F, j, PA, PB) do { \
        o[(j) >> 1] = __builtin_amdgcn_mfma_f32_32x32x16_bf16(PA, (bf16x8){F[0][0], F[0][1], F[0][2], F[0][3], F[1][0], F[1][1], F[1][2], F[1][3]}, o[(j) >> 1], 0, 0, 0); \
        o[(j) >> 1] = __builtin_amdgcn_mfma_f32_32x32x16_bf16(PB, (bf16x8){F[2][0], F[2][1], F[2][2], F[2][3], F[3][0], F[3][1], F[3][2], F[3][3]}, o[(j) >> 1], 0, 0, 0); } while (0)
#define WVA_W4() do { asm volatile("s_waitcnt lgkmcnt(4)" ::: "memory"); SBAR(); } while (0)
#define WVA_W0() do { asm volatile("s_waitcnt lgkmcnt(0)" ::: "memory"); SBAR(); } while (0)
#define WVA_2(j) do { WVA_RD(fb, (j) + 1); WVA_W4(); WVA_MM(fa, (j), pa0, pa1); SBAR(); WVA_RD(fa, (j) + 2); WVA_W4(); WVA_MM(fb, (j) + 1, pa2, pa3); SBAR(); } while (0)
    s16x4 fa[4], fb[4];
    SBAR();
    WVA_RD(fa, 0);
    WVA_2(0); WVA_2(2); WVA_2(4); WVA_2(6); WVA_2(8); WVA_2(10); WVA_2(12);
    WVA_RD(fb, 15); WVA_W4(); WVA_MM(fa, 14, pa0, pa1); SBAR(); WVA_W0(); WVA_MM(fb, 15, pa2, pa3); SBAR();
#undef WVA_2
#undef WVA_W0
#undef WVA_W4
#undef WVA_MM
#undef WVA_RD
#undef TRRD
}
__device__ __forceinline__ void wva_qk(f32x16& p0, f32x16& p1, const int* ka, const bf16x8* qr) {
#define KRD(dst, i) asm volatile("ds_read_b128 %0, %1 offset:%2" : "=&v"(dst) : "v"(ka[((i) >> 1) & 3]), "i"((((i) >> 1) >> 2) * 128 + ((i) & 1) * 8192) : "memory")
#define KW(n) do { asm volatile("s_waitcnt lgkmcnt(" #n ")" ::: "memory"); SBAR(); } while (0)
#define KMM(f, i) do { if ((i) & 1) p1 = __builtin_amdgcn_mfma_f32_32x32x16_bf16(f, qr[(i) >> 1], p1, 0, 0, 0); else p0 = __builtin_amdgcn_mfma_f32_32x32x16_bf16(f, qr[(i) >> 1], p0, 0, 0, 0); SBAR(); } while (0)
    bf16x8 f0, f1, f2, f3;
    p0 = f32x16{}; p1 = f32x16{};
    SBAR(); KRD(f0, 0); KRD(f1, 1); KRD(f2, 2);
    KRD(f3, 3); KW(3); KMM(f0, 0);   KRD(f0, 4); KW(3); KMM(f1, 1);   KRD(f1, 5); KW(3); KMM(f2, 2);   KRD(f2, 6); KW(3); KMM(f3, 3);
    KRD(f3, 7); KW(3); KMM(f0, 4);   KRD(f0, 8); KW(3); KMM(f1, 5);   KRD(f1, 9); KW(3); KMM(f2, 6);   KRD(f2, 10); KW(3); KMM(f3, 7);
    KRD(f3, 11); KW(3); KMM(f0, 8);  KRD(f0, 12); KW(3); KMM(f1, 9);  KRD(f1, 13); KW(3); KMM(f2, 10); KRD(f2, 14); KW(3); KMM(f3, 11);
    KRD(f3, 15); KW(3); KMM(f0, 12); KW(2); KMM(f1, 13); KW(1); KMM(f2, 14); KW(0); KMM(f3, 15);
#undef KMM
#undef KW
#undef KRD
}
__device__ __forceinline__ void wva_block(const SkaRef& R, char* lds, SKA_LAS unsigned char* ldsl, int cmode, float lam, const float* sg, bf16* HAo, int hap) {
    const int tid = ptid(), wid = __builtin_amdgcn_readfirstlane(tid >> 6), lane = tid & 63, r32 = lane & 31, hi = lane >> 5;
    const int NT = (R.P0 + 255) / KVBLK + 1;
    const int qlo = R.P0 + wid * 32, qm = qlo + r32 - 4 * hi;
    const char* gK; const char* gV0; const char* gV1;
    { const int row = tid >> 4, cp = tid & 15; gK = (const char*)R.K + row * 256 + ((cp ^ (row & 7)) << 4);
      const int sub = tid >> 5, kk = (sub >> 2) * 8 + ((tid >> 2) & 7), k = (kk & ~0xC) | ((kk & 4) << 1) | ((kk & 8) >> 1), c = (sub & 3) * 32 + (tid & 3) * 8;
      gV0 = (const char*)R.V0 + k * 256 + c * 2; gV1 = (const char*)R.V1 + k * 256 + c * 2; }
    const unsigned ldsw = (unsigned)wid * 1024u;
#define WVA_G(g, l) __builtin_amdgcn_global_load_lds((const unsigned*)(g), (SKA_LAS unsigned*)(ldsl + (l)), 16, 0, 0)
#define WVA_DMA(T_, S_) do { const size_t go_ = (size_t)(T_) * (KVBLK * 256); const unsigned kd_ = (unsigned)(S_) * 16384u + ldsw, vd_ = 49152u + (unsigned)(S_) * 32768u + ldsw; \
        WVA_G(gK + go_, kd_); WVA_G(gK + go_ + 8192, kd_ + 8192); WVA_G(gV0 + go_, vd_); WVA_G(gV0 + go_ + 8192, vd_ + 8192); WVA_G(gV1 + go_, vd_ + 16384); WVA_G(gV1 + go_ + 8192, vd_ + 24576); } while (0)
    float* st = (float*)(lds + WVA_STATS) + wid * 64;
    const int vb0 = (int)(uintptr_t)(lds + 49152) + v_rd_base(lane);
    int kb0[4];
#pragma unroll
    for (int dd = 0; dd < 4; ++dd) kb0[dd] = (int)(uintptr_t)lds + KSWZ(r32, (dd * 16 + hi * 8) * 2);
#define WVA_RESC(a) do { if (__any((a) < 1.f)) { if (hi == 0) st[r32] = (a); asm volatile("s_waitcnt lgkmcnt(0)" ::: "memory");              \
        _Pragma("unroll") for (int d_ = 0; d_ < 8; ++d_) _Pragma("unroll") for (int r = 0; r < 16; ++r) o[d_][r] *= st[crow(r, hi)]; } } while (0)
    WVA_DMA(0, 0); if (NT > 1) WVA_DMA(1, 1);
    bf16x8 qr[8];
#pragma unroll
    for (int d0 = 0; d0 < 8; ++d0) qr[d0] = *reinterpret_cast<const bf16x8*>(R.Q + (size_t)(wid * 32 + r32) * D + d0 * 16 + hi * 8);
    float m_reg = -1e30f, l_reg = 0; f32x16 o[8] = {};
    asm volatile("s_waitcnt vmcnt(0)" ::: "memory"); __syncthreads();
    int sr = 0, sw = 2;
#pragma nounroll
    for (int t = 0; t < NT; ++t) {
        if (t + 2 < NT) WVA_DMA(t + 2, sw);
        if (t * KVBLK <= qlo + 31) {
        f32x16 p0, p1; float mn, al; bf16x8 pa0, pa1, pa2, pa3;
        { int ka[4];
#pragma unroll
          for (int dd = 0; dd < 4; ++dd) ka[dd] = kb0[dd] + sr * 16384;
          wva_qk(p0, p1, ka, qr); }
        { const int kb = t * KVBLK; if (kb + KVBLK - 1 > qlo) mask_tile(p0, p1, qm - kb, (unsigned)SKV); }
        partialSM(p0, p1, m_reg, mn, al); finishSM(p0, p1, al, l_reg, pa0, pa1, pa2, pa3);
        WVA_RESC(al); SBAR();
        wva_pv(o, vb0 + sr * 32768, pa0, pa1, pa2, pa3);
        }
        if (t + 2 < NT) asm volatile("s_waitcnt vmcnt(6)" ::: "memory"); else asm volatile("s_waitcnt vmcnt(0)" ::: "memory");
        __syncthreads();
        sr = sr == 2 ? 0 : sr + 1; sw = sw == 2 ? 0 : sw + 1;
    }
    if (hi == 0) st[32 + r32] = l_reg; asm volatile("s_waitcnt lgkmcnt(0)" ::: "memory");
    float rli[16];
#pragma unroll
    for (int r = 0; r < 16; ++r) rli[r] = __builtin_amdgcn_rcpf(st[32 + crow(r, hi)]);
    if (cmode == 0) {
        bf16* Ow = R.O + (size_t)(wid * 32) * 256 + r32;
#pragma unroll
        for (int r = 0; r < 16; ++r) { const int orow = crow(r, hi);
#pragma unroll
            for (int d0 = 0; d0 < 8; ++d0) { const float v = o[d0][r] * rli[r]; const float vn = __shfl_xor(v, 1);
                if ((r32 & 1) == 0) *(unsigned*)(Ow + (size_t)orow * 256 + d0 * 32) = cvtpk(v, vn); } }
    } else {
        char* wl = lds + wid * 16384; const bf16* O0w = R.O + (size_t)(wid * 32) * 256;
#pragma unroll
        for (int hb = 0; hb < 2; ++hb) { u32x4 tq[8];
#pragma unroll
            for (int j = 0; j < 8; ++j) tq[j] = *reinterpret_cast<const u32x4*>(O0w + (size_t)(2 * (hb * 8 + j) + hi) * 256 + r32 * 8);
#pragma unroll
            for (int j = 0; j < 8; ++j) *reinterpret_cast<u32x4*>(wl + (2 * (hb * 8 + j) + hi) * 512 + r32 * 16) = tq[j]; }
        float sg8[8];
#pragma unroll
        for (int d0 = 0; d0 < 8; ++d0) sg8[d0] = sg[d0 * 32 + r32] * 0.8f;
        asm volatile("s_waitcnt lgkmcnt(0)" ::: "memory");
        bf16* Hw = HAo + (size_t)(wid * 32) * hap + r32;
#pragma unroll
        for (int r = 0; r < 16; ++r) { const int orow = crow(r, hi); float df[8]; float ss = 0.f;
#pragma unroll
            for (int d0 = 0; d0 < 8; ++d0) { const unsigned short h0 = *reinterpret_cast<const unsigned short*>(wl + orow * 512 + (d0 * 32 + r32) * 2);
                df[d0] = __builtin_bit_cast(float, (unsigned)h0 << 16) - lam * (o[d0][r] * rli[r]); ss += df[d0] * df[d0]; }
            ss += __shfl_xor(ss, 1); ss += __shfl_xor(ss, 2); ss += __shfl_xor(ss, 4); ss += __shfl_xor(ss, 8); ss += __shfl_xor(ss, 16);
            const float rs = 1.0f / sqrtf(ss * (1.0f / 256.f) + 1e-6f);
#pragma unroll
            for (int d0 = 0; d0 < 8; ++d0) { const float v = df[d0] * rs * sg8[d0]; const float vn = __shfl_xor(v, 1);
                if ((r32 & 1) == 0) *(unsigned*)(Hw + (size_t)orow * hap + d0 * 32) = cvtpk(v, vn); } }
        __syncthreads();
    }
#undef WVA_RESC
#undef WVA_DMA
#undef WVA_G
}
}
namespace att {
__device__ __forceinline__ void wvh_qk(f32x16& s, const int* ka, const bf16x8* qr) {
#define KRD(dst, i) asm volatile("ds_read_b128 %0, %1 offset:%2" : "=&v"(dst) : "v"(ka[(i) & 3]), "i"(((i) >> 2) * 128) : "memory")
#define KW(n) do { asm volatile("s_waitcnt lgkmcnt(" #n ")" ::: "memory"); SBAR(); } while (0)
#define KMM(f, i) do { s = __builtin_amdgcn_mfma_f32_32x32x16_bf16(f, qr[i], s, 0, 0, 0); SBAR(); } while (0)
    bf16x8 f0, f1, f2;
    s = f32x16{};
    SBAR(); KRD(f0, 0); KRD(f1, 1);
    KRD(f2, 2); KW(2); KMM(f0, 0);   KRD(f0, 3); KW(2); KMM(f1, 1);   KRD(f1, 4); KW(2); KMM(f2, 2);
    KRD(f2, 5); KW(2); KMM(f0, 3);   KRD(f0, 6); KW(2); KMM(f1, 4);   KRD(f1, 7); KW(2); KMM(f2, 5);
    KW(1); KMM(f0, 6); KW(0); KMM(f1, 7);
#undef KMM
#undef KW
#undef KRD
}
__device__ __forceinline__ void wvh_block(const SkaRef& R, char* lds, SKA_LAS unsigned char* ldsl, int cmode, float lam, const float* sg, bf16* HAo, int hap) {
    const int tid = ptid(), wid = __builtin_amdgcn_readfirstlane(tid >> 6), lane = tid & 63, r32 = lane & 31, hi = lane >> 5;
    const int NT = (R.P0 + 255) / KVBLK + 1;
    const int qlo = R.P0 + wid * 32, qm = qlo + r32 - 4 * hi;
    const char* gK; const char* gV0; const char* gV1;
    { const int row = tid >> 4, cp = tid & 15; gK = (const char*)R.K + row * 256 + ((cp ^ (row & 7)) << 4);
      const int sub = tid >> 5, kk = (sub >> 2) * 8 + ((tid >> 2) & 7), k = (kk & ~0xC) | ((kk & 4) << 1) | ((kk & 8) >> 1), c = (sub & 3) * 32 + (tid & 3) * 8;
      gV0 = (const char*)R.V0 + k * 256 + c * 2; gV1 = (const char*)R.V1 + k * 256 + c * 2; }
    const unsigned ldsw = (unsigned)wid * 1024u;
#define WVA_G(g, l) __builtin_amdgcn_global_load_lds((const unsigned*)(g), (SKA_LAS unsigned*)(ldsl + (l)), 16, 0, 0)
#define WVH_DMAK(T_, S_) do { const size_t go_ = (size_t)(T_) * (KVBLK * 256); const unsigned kd_ = (unsigned)(S_) * 16384u + ldsw; WVA_G(gK + go_, kd_); WVA_G(gK + go_ + 8192, kd_ + 8192); } while (0)
#define WVH_DMAV(T_, S_) do { const size_t go_ = (size_t)(T_) * (KVBLK * 256); const unsigned vd_ = 49152u + (unsigned)(S_) * 32768u + ldsw; \
        WVA_G(gV0 + go_, vd_); WVA_G(gV0 + go_ + 8192, vd_ + 8192); WVA_G(gV1 + go_, vd_ + 16384); WVA_G(gV1 + go_ + 8192, vd_ + 24576); } while (0)
    float* st = (float*)(lds + WVA_STATS) + wid * 64;
    const int vb0 = (int)(uintptr_t)(lds + 49152) + v_rd_base(lane);
    const int kb0 = r32 * 256 + ((hi << 4) ^ ((r32 & 7) << 4)), kbase = (int)(uintptr_t)lds;
#define WVA_RESC(a) do { if (__any((a) < 1.f)) { if (hi == 0) st[r32] = (a); asm volatile("s_waitcnt lgkmcnt(0)" ::: "memory");              \
        _Pragma("unroll") for (int d_ = 0; d_ < 8; ++d_) _Pragma("unroll") for (int r = 0; r < 16; ++r) o[d_][r] *= st[crow(r, hi)]; } } while (0)
    WVH_DMAK(0, 0); WVH_DMAV(0, 0); WVH_DMAK(1, 1);
    bf16x8 qr[8];
#pragma unroll
    for (int d0 = 0; d0 < 8; ++d0) qr[d0] = *reinterpret_cast<const bf16x8*>(R.Q + (size_t)(wid * 32 + r32) * D + d0 * 16 + hi * 8);
    float m_reg = -1e30f, l_reg = 0; f32x16 o[8] = {};
    float al0 = 1.f, al1 = 1.f; bf16x8 pa0 = {}, pa1 = {}, pb0 = {}, pb1 = {}; bool carry = false;
    asm volatile("s_waitcnt vmcnt(0)" ::: "memory"); __syncthreads();
    const bool typeB = wid >= 4;
    int sk = 0, skw = 2, sv = 0, svp = 2, svw = 1;
#define WVH_SCORE(H_, PA0, PA1, AL) do { f32x16 s_; float mn_; int ka_[4];                                                                      \
        _Pragma("unroll") for (int dd = 0; dd < 4; ++dd) ka_[dd] = (kb0 ^ (dd << 5)) + kbase + (H_) * 8192 + sk * 16384;                                \
        __builtin_amdgcn_s_setprio(1); wvh_qk(s_, ka_, qr); __builtin_amdgcn_s_setprio(0);                                                      \
        { const int kb_ = i * KVBLK + 32 * (H_); if (kb_ + 31 > qlo) ska_mask(s_, qm - kb_); }                                                  \
        ska_sm_a(s_, m_reg, mn_, AL); ska_sm_b(s_, AL, l_reg, PA0, PA1); SBAR(); } while (0)
#define WVH_PV(VS_, H_, PA0, PA1, AL) do { WVA_RESC(AL); SBAR(); __builtin_amdgcn_s_setprio(1); ska_pv(o, vb0 + (VS_) * 32768 + (H_) * 8192, PA0, PA1); __builtin_amdgcn_s_setprio(0); } while (0)
#pragma nounroll
    for (int i = 0; i <= NT; ++i) {
        if (i + 1 < NT) WVH_DMAV(i + 1, svw);
        if (i + 2 < NT) WVH_DMAK(i + 2, skw);
        if (carry) { WVH_PV(svp, 1, pb0, pb1, al1); carry = false; }
        if (i < NT) {
            const bool act0 = i * KVBLK <= qlo + 31, act1 = i * KVBLK + 32 <= qlo + 31;
            if (act0) WVH_SCORE(0, pa0, pa1, al0);
            if (act0) WVH_PV(sv, 0, pa0, pa1, al0);
            if (act1) WVH_SCORE(1, pb0, pb1, al1);
            if (act1) { if (typeB) carry = true; }
            if (act1 && !typeB) WVH_PV(sv, 1, pb0, pb1, al1);
        }
        if (i + 2 < NT) asm volatile("s_waitcnt vmcnt(2)" ::: "memory"); else asm volatile("s_waitcnt vmcnt(0)" ::: "memory");
        __syncthreads();
        sk = sk == 2 ? 0 : sk + 1; skw = skw == 2 ? 0 : skw + 1; svp = sv; sv = sv == 2 ? 0 : sv + 1; svw = svw == 2 ? 0 : svw + 1;
    }
#undef WVH_PV
#undef WVH_SCORE
#undef WVH_DMAK
#undef WVH_DMAV
    if (hi == 0) st[32 + r32] = l_reg; asm volatile("s_waitcnt lgkmcnt(0)" ::: "memory");
    float rli[16];
#pragma unroll
    for (int r = 0; r < 16; ++r) rli[r] = __builtin_amdgcn_rcpf(st[32 + crow(r, hi)]);
    if (cmode == 0) {
        bf16* Ow = R.O + (size_t)(wid * 32) * 256 + r32;
#pragma unroll
        for (int r = 0; r < 16; ++r) { const int orow = crow(r, hi);
#pragma unroll
            for (int d0 = 0; d0 < 8; ++d0) { const float v = o[d0][r] * rli[r]; const float vn = __shfl_xor(v, 1);
                if ((r32 & 1) == 0) *(unsigned*)(Ow + (size_t)orow * 256 + d0 * 32) = cvtpk(v, vn); } }
    } else {
        char* wl = lds + wid * 16384; const bf16* O0w = R.O + (size_t)(wid * 32) * 256;
#pragma unroll
        for (int hb = 0; hb < 2; ++hb) { u32x4 tq[8];
#pragma unroll
            for (int j = 0; j < 8; ++j) tq[j] = *reinterpret_cast<const u32x4*>(O0w + (size_t)(2 * (hb * 8 + j) + hi) * 256 + r32 * 8);
#pragma unroll
            for (int j = 0; j < 8; ++j) *reinterpret_cast<u32x4*>(wl + (2 * (hb * 8 + j) + hi) * 512 + r32 * 16) = tq[j]; }
        float sg8[8];
#pragma unroll
        for (int d0 = 0; d0 < 8; ++d0) sg8[d0] = sg[d0 * 32 + r32] * 0.8f;
        asm volatile("s_waitcnt lgkmcnt(0)" ::: "memory");
        bf16* Hw = HAo + (size_t)(wid * 32) * hap + r32;
#pragma unroll
        for (int r = 0; r < 16; ++r) { const int orow = crow(r, hi); float df[8]; float ss = 0.f;
#pragma unroll
            for (int d0 = 0; d0 < 8; ++d0) { const unsigned short h0 = *reinterpret_cast<const unsigned short*>(wl + orow * 512 + (d0 * 32 + r32) * 2);
                df[d0] = __builtin_bit_cast(float, (unsigned)h0 << 16) - lam * (o[d0][r] * rli[r]); ss += df[d0] * df[d0]; }
            ss += __shfl_xor(ss, 1); ss += __shfl_xor(ss, 2); ss += __shfl_xor(ss, 4); ss += __shfl_xor(ss, 8); ss += __shfl_xor(ss, 16);
            const float rs = 1.0f / sqrtf(ss * (1.0f / 256.f) + 1e-6f);
#pragma unroll
            for (int d0 = 0; d0 < 8; ++d0) { const float v = df[d0] * rs * sg8[d0]; const float vn = __shfl_xor(v, 1);
                if ((r32 & 1) == 0) *(unsigned*)(Hw + (size_t)orow * hap + d0 * 32) = cvtpk(v, vn); } }
        __syncthreads();
    }
#undef WVA_RESC
#undef WVA_G
}
}
constexpr int NWAVES = 8;
constexpr int BATCH = 4, SEQ = 4096, D = 2048, M = BATCH * SEQ, FF = 5632, QKVD = 6144, NH = 8, HD = 128, VD = 256;
constexpr int NGRP = 128, SGRP = 16, SST = 64, CH = 16, NCH = SEQ / CH  , SROWS = NGRP * BATCH * NCH  , SLD = 384;
constexpr float NORM_EPS = 1e-6f;
constexpr int NPH = 24;

#ifndef ATT_WVA
#define ATT_WVA 1
#endif
#ifndef ATT_SKA
#define ATT_SKA 1
#endif
#ifndef ATT_RSA
#define ATT_RSA 1
#endif
#ifndef G2_KREV
#define G2_KREV 0
#endif
#ifndef G1_SPLIT
#define G1_SPLIT 0
#endif
#ifndef G1_WGM
#define G1_WGM 8
#endif
#ifndef OTH_WGM
#define OTH_WGM 8
#endif
#ifndef G2_WGM
#define G2_WGM 4
#endif
#ifndef KPAD
#define KPAD 0
#endif
#ifndef FPAD
#define FPAD 0
#endif
constexpr int KP = D + KPAD, FP = FF + FPAD;
constexpr size_t MiB = 1u << 20;
constexpr size_t al1m(size_t x) { return (x + MiB - 1) / MiB * MiB; }
constexpr size_t WS_CTL = 0, CTL_ZERO_BYTES = 1 * MiB;
constexpr size_t WS_COEF = 1 * MiB;
constexpr size_t WS_ROPE = 2 * MiB;
constexpr size_t WS_XBUF = 4 * MiB;
constexpr size_t WS_WIN = 8 * MiB;
constexpr size_t WS_WOUT = al1m(WS_WIN + (size_t)4 * 2 * FF * KP * 2);
constexpr size_t WS_WQKV = al1m(WS_WOUT + (size_t)4 * D * FP * 2);
constexpr size_t WS_WO = al1m(WS_WQKV + (size_t)QKVD * KP * 2);
constexpr size_t WS_WGLU = al1m(WS_WO + (size_t)D * KP * 2);
constexpr size_t WS_TV = al1m(WS_WGLU + (size_t)2 * D * KP * 2);
constexpr size_t WS_SW = al1m(WS_TV + (size_t)NGRP * 256 * SLD * 2);
constexpr size_t WS_HA = al1m(WS_SW + (size_t)NGRP * 256 * 256 * 2);
constexpr size_t WS_ACT = al1m(WS_HA + (size_t)M * KP * 2);
constexpr size_t WS_QKRAW = al1m(WS_ACT + (size_t)M * FP * 2);
constexpr size_t WS_XH = WS_QKRAW;
constexpr size_t WS_QH = al1m(WS_QKRAW + (size_t)M * 4096 * 2);
constexpr size_t WS_KH = al1m(WS_QH + (size_t)M * 2048 * 2);
constexpr size_t WS_VH = al1m(WS_KH + (size_t)M * 2048 * 2);
constexpr size_t WS_OH = al1m(WS_VH + (size_t)M * 2048 * 2);
constexpr size_t WS_HS2 = al1m(WS_OH + (size_t)M * 4096 * 2);
constexpr size_t WS_SLOC = al1m(WS_HS2 + (size_t)SROWS * SLD * 2);
constexpr size_t WS_END = al1m(WS_SLOC + (size_t)SROWS * 128 * 4);
static_assert(WS_END <= (size_t)1400 * MiB, "workspace map");
constexpr int CW_TMO = 0, CW_BAR = 4096, CW_Q = 8192, CW_PCNT = 65536;

constexpr int RING_BYTES = 131072, LDSCTL_OFF = 147456, MISC_OFF = LDSCTL_OFF + 320, LDS_BYTES = 155648;

#define GAS __attribute__((address_space(1)))
#define LAS __attribute__((address_space(3)))
typedef unsigned short bf16;
typedef unsigned v4u __attribute__((ext_vector_type(4)));
typedef unsigned v2u __attribute__((ext_vector_type(2)));
typedef float f32x4 __attribute__((ext_vector_type(4)));
typedef GAS unsigned gu32;
#define RLX_AGENT __ATOMIC_RELAXED, __HIP_MEMORY_SCOPE_AGENT
#define LDS_WAIT() asm volatile("s_waitcnt lgkmcnt(0)" ::: "memory")
__device__ __forceinline__ unsigned f2bf(float f) { unsigned u = __builtin_bit_cast(unsigned, f); return (u + 0x7fffu + ((u >> 16) & 1u)) >> 16; }
__device__ __forceinline__ unsigned pk2(float lo, float hi) { return f2bf(lo) | (f2bf(hi) << 16); }
__device__ __forceinline__ float bf_lo(unsigned w) { return __builtin_bit_cast(float, w << 16); }
__device__ __forceinline__ float bf_hi(unsigned w) { return __builtin_bit_cast(float, w & 0xffff0000u); }
__device__ __forceinline__ float wave_sum(float v) {
#pragma unroll
    for (int o = 1; o < 64; o <<= 1) v += __shfl_xor(v, o);
    return v;
}

#ifndef FUSE_NORM
#define FUSE_NORM 1
#endif
#ifndef SSM_CHAIN
#define SSM_CHAIN 1
#endif
#ifndef FUSE_SSMN
#define FUSE_SSMN 1
#endif
#ifndef FUSE_GLUN
#define FUSE_GLUN 0
#endif
#ifndef DEFER_W
#define DEFER_W 1
#endif
#ifndef DEFER_QUOTA
#define DEFER_QUOTA 16
#endif
#ifndef Q_CHUNK
#define Q_CHUNK 16
#endif
#ifndef QKV_MREV
#define QKV_MREV 0
#endif
#ifndef OTH_MREV
#define OTH_MREV 1
#endif
#ifndef G1_NREV
#define G1_NREV 0
#endif
#ifndef G1_MREV
#define G1_MREV 0
#endif
#ifndef G2_MREV
#define G2_MREV 1
#endif
#ifndef PROBE_XNAN
#define PROBE_XNAN 0
#endif
#ifndef PROBE_ATT
#define PROBE_ATT 0
#endif
#ifndef PROBE_DUP
#define PROBE_DUP -1
#endif
#define NREP(k) (((k) == PROBE_DUP || (PROBE_DUP == 200 && ((k) == 6 || (k) == 8)) || (PROBE_DUP == 201 && (k) >= 16 && (k) <= 19)) ? 2 : ((k) + 500 == PROBE_DUP ? 5 : 1))
#ifdef ONLY_PHASE
#define PH_EN(k) ((k) == (ONLY_PHASE))
#else
#define PH_EN(k) true
#endif

#define XB_TMO      128
#define XB_XCNT(j)  (256  + 64 * (j))
#define XB_XSUB(j)  (1280 + 64 * (j))
#define XB_XGEN(j)  (2304 + 64 * (j))
#define XB_TOP      3328
#define XB_TOPGEN   3392
#define XCD_BAR_WORDS 3456
#define XB_SPIN_CAP (1u << 18)

__device__ __forceinline__ unsigned xb_ld(unsigned* p)              { return __hip_atomic_load(p, __ATOMIC_RELAXED, __HIP_MEMORY_SCOPE_AGENT); }
__device__ __forceinline__ unsigned xb_add(unsigned* p, unsigned v) { return __hip_atomic_fetch_add(p, v, __ATOMIC_RELAXED, __HIP_MEMORY_SCOPE_AGENT); }
__device__ __forceinline__ unsigned xb_xcc_id() { return (unsigned)__builtin_amdgcn_s_getreg((3 << 11) | 20) & 0xFu; }
#define XB_SPIN(cond, bar) do { unsigned _sp = 0; while (cond) { __builtin_amdgcn_s_sleep(1); \
    if ((++_sp & 255u) == 0u) { if (xb_ld(&(bar)[XB_TMO])) break; if (_sp > XB_SPIN_CAP) { atomicAdd(&(bar)[XB_TMO], 1u); break; } } } } while (0)

struct XcdBarrier {
    unsigned* bar; unsigned x;
    volatile LAS unsigned* st;
};

__device__ __forceinline__ XcdBarrier xcd_barrier_post(unsigned* bar, volatile LAS unsigned* st) {
    XcdBarrier b; b.bar = bar; b.x = xb_xcc_id(); b.st = st;
    if (threadIdx.x == 0) (void)xb_add(&bar[XB_XCNT(b.x)], 1u);
    return b;
}
__device__ __forceinline__ void xcd_barrier_complete(unsigned* bar, unsigned x, unsigned& nloc, unsigned& nx) {
    const unsigned G = gridDim.x * gridDim.y * gridDim.z;
    unsigned sum, cnt, mine, sp = 0u;
    for (;;) {
        sum = 0u; cnt = 0u; mine = 0u;
#pragma unroll
        for (unsigned j = 0; j < 16; ++j) { const unsigned c = xb_ld(&bar[XB_XCNT(j)]); sum += c; cnt += (c > 0u) ? 1u : 0u; mine = (j == x) ? c : mine; }
        if (sum == G) break;
        __builtin_amdgcn_s_sleep(1);
        if ((++sp & 255u) == 0u) { if (xb_ld(&bar[XB_TMO])) break; if (sp > XB_SPIN_CAP) { atomicAdd(&bar[XB_TMO], 1u); break; } }
    }
    nloc = mine > 0u ? mine : 1u; nx = cnt > 0u ? cnt : 1u;
}

__device__ __forceinline__ void xcd_barrier(const XcdBarrier& b) {
    asm volatile("s_waitcnt vmcnt(0)" ::: "memory");
    __syncthreads();
    if (threadIdx.x == 0) {
        unsigned* bar = b.bar;
        __builtin_amdgcn_s_waitcnt(0);
        unsigned nloc = b.st[0], nx = b.st[1];
        if (nloc == 0u) { xcd_barrier_complete(bar, b.x, nloc, nx); b.st[0] = nloc; b.st[1] = nx; }
        const unsigned old = xb_add(&bar[XB_XSUB(b.x)], 1u);
        const unsigned gen = old / nloc;
        if (old + 1u == (gen + 1u) * nloc) {
            __builtin_amdgcn_fence(__ATOMIC_RELEASE, "agent");
            asm volatile("s_waitcnt vmcnt(0)" ::: "memory");
            const unsigned og = xb_add(&bar[XB_TOP], 1u);
            const unsigned tg = og / nx;
            if (og + 1u == (tg + 1u) * nx) xb_add(&bar[XB_TOPGEN], 1u);
            else XB_SPIN(xb_ld(&bar[XB_TOPGEN]) == tg, bar);
            __builtin_amdgcn_fence(__ATOMIC_ACQUIRE, "agent");
            xb_add(&bar[XB_XGEN(b.x)], 1u);
            asm volatile("s_waitcnt vmcnt(0)" ::: "memory");
        } else {
            XB_SPIN(xb_ld(&bar[XB_XGEN(b.x)]) == gen, bar);
            __builtin_amdgcn_fence(__ATOMIC_ACQUIRE, "agent");
            asm volatile("s_waitcnt vmcnt(0)" ::: "memory");
        }
    }
    __syncthreads();
}

struct Args { const float* in[23]; float* out; unsigned char* ws; int ph_lo, ph_hi; };

struct TrItem { const float* W; bf16* WT; int ldt, N, k0, n0, drow0; };
__device__ __forceinline__ void transpose_load(const TrItem& t, float (&wv)[32], int lane) {
#pragma unroll
    for (int i = 0; i < 32; ++i) { const int kk = 2 * i + (lane >> 5); wv[i] = __builtin_nontemporal_load(t.W + (size_t)(t.k0 + kk) * t.N + t.n0 + (lane & 31)); }
}
__device__ __forceinline__ void transpose_finish(const TrItem& t, const float (&wv)[32], LAS float* scr, int lane) {
#pragma unroll
    for (int i = 0; i < 32; ++i) { const int kk = 2 * i + (lane >> 5); scr[kk * 33 + (lane & 31)] = wv[i]; }
    LDS_WAIT(); asm volatile("" ::: "memory");
    const int c = lane & 7;
#pragma unroll
    for (int j = 0; j < 4; ++j) { const int n = (lane >> 3) + 8 * j; const LAS float* s = scr + (8 * c) * 33 + n;
        v4u o; o.x = pk2(s[0 * 33], s[1 * 33]); o.y = pk2(s[2 * 33], s[3 * 33]); o.z = pk2(s[4 * 33], s[5 * 33]); o.w = pk2(s[6 * 33], s[7 * 33]);
        *(GAS v4u*)(t.WT + (size_t)(t.drow0 + n) * t.ldt + t.k0 + 8 * c) = o; }
    LDS_WAIT(); asm volatile("" ::: "memory");
}
__device__ __forceinline__ int paired_row(int n0, int half_n) { const int part = n0 / half_n, j = n0 - part * half_n; return 256 * (j >> 7) + 128 * part + (j & 127); }

__device__ __forceinline__ void p0_transposes(const Args& a, LAS unsigned char* lds, int gw, int ngw, int wave, int lane) {
    LAS float* scr = (LAS float*)(lds + wave * 16384);
    constexpr int I_IN = (D / 64) * (2 * FF / 32), I_OUT = (FF / 64) * (D / 32), I_QKV = (D / 64) * (QKVD / 32), I_O = (D / 64) * (D / 32), I_GLU = (D / 64) * (2 * D / 32);
    constexpr int NITEMS = 4 * I_IN + 4 * I_OUT + I_QKV + I_O + I_GLU;
    unsigned* qctr = (unsigned*)(a.ws + WS_CTL) + CW_Q;
    for (;;) {
      int it0 = 0; if (lane == 0) it0 = (int)__hip_atomic_fetch_add(qctr, (unsigned)Q_CHUNK, __ATOMIC_RELAXED, __HIP_MEMORY_SCOPE_AGENT);
      it0 = __builtin_amdgcn_readfirstlane(it0);
      if (it0 >= NITEMS) break;
      const int itE = it0 + Q_CHUNK < NITEMS ? it0 + Q_CHUNK : NITEMS;
      auto decode = [&](int it) { TrItem t; int r = it;
        if (r < 4 * I_IN) { const int f = r / I_IN; r -= f * I_IN; const int nb = 2 * FF / 32, kb = r / nb, n0 = 32 * (r % nb);
            t = TrItem{a.in[6] + (size_t)f * D * 2 * FF, (bf16*)(a.ws + WS_WIN) + (size_t)f * 2 * FF * KP, KP, 2 * FF, 64 * kb, n0, paired_row(n0, FF)}; return t; }
        r -= 4 * I_IN;
        if (r < 4 * I_OUT) { const int f = r / I_OUT; r -= f * I_OUT; const int nb = D / 32, kb = r / nb, n0 = 32 * (r % nb);
            t = TrItem{a.in[7] + (size_t)f * FF * D, (bf16*)(a.ws + WS_WOUT) + (size_t)f * D * FP, FP, D, 64 * kb, n0, n0}; return t; }
        r -= 4 * I_OUT;
        if (r < I_QKV) { const int nb = QKVD / 32, kb = r / nb, n0 = 32 * (r % nb); t = TrItem{a.in[8], (bf16*)(a.ws + WS_WQKV), KP, QKVD, 64 * kb, n0, n0}; return t; }
        r -= I_QKV;
        if (r < I_O) { const int nb = D / 32, kb = r / nb, n0 = 32 * (r % nb); t = TrItem{a.in[9], (bf16*)(a.ws + WS_WO), KP, D, 64 * kb, n0, n0}; return t; }
        r -= I_O;
        { const int nb = 2 * D / 32, kb = r / nb, n0 = 32 * (r % nb); t = TrItem{a.in[22], (bf16*)(a.ws + WS_WGLU), KP, 2 * D, 64 * kb, n0, paired_row(n0, D)}; return t; } };
      for (int it = it0; it < itE; it += 2) {
        float wa[32], wb[32]; const TrItem ta = decode(it); const bool two = it + 1 < itE; const TrItem tb = decode(two ? it + 1 : it);
        transpose_load(ta, wa, lane); if (two) transpose_load(tb, wb, lane);
        transpose_finish(ta, wa, scr, lane); if (two) transpose_finish(tb, wb, scr, lane);
      }
    }
}

struct TrItemW { const float* W; bf16* WT; int ldt, N, k0, n0, half; };
constexpr int TRW_TI = (D / 64) * (2 * FF / 256) / 2, TRW_TO = (FF / 64) * (D / 256) / 2, TRW_TQ = (D / 64) * (QKVD / 256) / 2, TRW_TOO = (D / 64) * (D / 256) / 2, TRW_TG = (D / 64) * (2 * D / 256) / 2;
constexpr int TRW_NTK = 4 * TRW_TI + 4 * TRW_TO + TRW_TQ + TRW_TOO + TRW_TG, TRW_N0 = TRW_TI + TRW_TO, TRW_N1 = TRW_NTK - TRW_N0;
__device__ __forceinline__ int trw_ticket(int list, int j) {
    if (list == 0) return j < TRW_TI ? j : 4 * TRW_TI + (j - TRW_TI);
    if (j < 3 * TRW_TI) return TRW_TI + j;
    j -= 3 * TRW_TI; if (j < 3 * TRW_TO) return 4 * TRW_TI + TRW_TO + j;
    return 4 * TRW_TI + 4 * TRW_TO + (j - 3 * TRW_TO);
}
__device__ __forceinline__ void p0_transposes_wg(const Args& a, LAS unsigned char* lds, int tid, int wave, int lane, unsigned* qctr, int list, int nl, int quota) {
    constexpr int PIT = 260;
    LAS float* T0 = (LAS float*)lds; LAS float* T1 = T0 + 64 * PIT; LAS int* tick = (LAS int*)(lds + 2 * 64 * PIT * 4);
    constexpr int J_IN = (D / 64) * (2 * FF / 256), J_OUT = (FF / 64) * (D / 256), J_QKV = (D / 64) * (QKVD / 256), J_O = (D / 64) * (D / 256);
    auto decode = [&](int it) { TrItemW t; int r = it;
        if (r < 4 * J_IN) { const int f = r / J_IN; r -= f * J_IN; const int nb = 2 * FF / 256; t = TrItemW{a.in[6] + (size_t)f * D * 2 * FF, (bf16*)(a.ws + WS_WIN) + (size_t)f * 2 * FF * KP, KP, 2 * FF, 64 * (r / nb), 256 * (r % nb), FF}; return t; }
        r -= 4 * J_IN;
        if (r < 4 * J_OUT) { const int f = r / J_OUT; r -= f * J_OUT; const int nb = D / 256; t = TrItemW{a.in[7] + (size_t)f * FF * D, (bf16*)(a.ws + WS_WOUT) + (size_t)f * D * FP, FP, D, 64 * (r / nb), 256 * (r % nb), 0}; return t; }
        r -= 4 * J_OUT;
        if (r < J_QKV) { const int nb = QKVD / 256; t = TrItemW{a.in[8], (bf16*)(a.ws + WS_WQKV), KP, QKVD, 64 * (r / nb), 256 * (r % nb), 0}; return t; }
        r -= J_QKV;
        if (r < J_O) { const int nb = D / 256; t = TrItemW{a.in[9], (bf16*)(a.ws + WS_WO), KP, D, 64 * (r / nb), 256 * (r % nb), 0}; return t; }
        r -= J_O;
        { const int nb = 2 * D / 256; t = TrItemW{a.in[22], (bf16*)(a.ws + WS_WGLU), KP, 2 * D, 64 * (r / nb), 256 * (r % nb), D}; return t; } };
#define TRW_LOAD(t, r) do { _Pragma("unroll") for (int i = 0; i < 8; ++i) r[i] = __builtin_nontemporal_load((const GAS f32x4*)((t).W + (size_t)((t).k0 + 8 * wave + i) * (t).N + (t).n0) + lane); } while (0)
#define TRW_WRITE(T, r) do { _Pragma("unroll") for (int i = 0; i < 8; ++i) *(LAS f32x4*)((T) + (8 * wave + i) * PIT + 4 * lane) = r[i]; } while (0)
#define TRW_OUT(T, t) do { const int n_ = lane & 31, nw_ = (t).n0 + 32 * wave, dr_ = ((t).half ? paired_row(nw_, (t).half) : nw_) + n_;                        \
        _Pragma("unroll") for (int j = 0; j < 4; ++j) { const int c_ = (lane >> 5) + 2 * j; const LAS float* s_ = (T) + (8 * c_) * PIT + 32 * wave + n_;          \
            v4u o_; o_.x = pk2(s_[0 * PIT], s_[1 * PIT]); o_.y = pk2(s_[2 * PIT], s_[3 * PIT]); o_.z = pk2(s_[4 * PIT], s_[5 * PIT]); o_.w = pk2(s_[6 * PIT], s_[7 * PIT]); \
            *(GAS v4u*)((t).WT + (size_t)dr_ * (t).ldt + (t).k0 + 8 * c_) = o_; } } while (0)
    int nf = 0;
#define TRW_FETCH() ((nf < quota) ? (++nf, (int)__hip_atomic_fetch_add(qctr, 1u, __ATOMIC_RELAXED, __HIP_MEMORY_SCOPE_AGENT)) : nl)
    __syncthreads();
    if (tid == 0) { tick[0] = TRW_FETCH(); tick[1] = TRW_FETCH(); tick[2] = TRW_FETCH(); }
    __syncthreads();
    int cur = __builtin_amdgcn_readfirstlane(tick[0]), nx1 = __builtin_amdgcn_readfirstlane(tick[1]), nx2 = __builtin_amdgcn_readfirstlane(tick[2]);
    __syncthreads();
    f32x4 r0a[8], r0b[8], r1a[8], r1b[8];
    if (cur < nl) { const int g_ = trw_ticket(list, cur); const TrItemW ta = decode(2 * g_), tb = decode(2 * g_ + 1); TRW_LOAD(ta, r0a); TRW_LOAD(tb, r0b); }
    if (nx1 < nl) { const int g_ = trw_ticket(list, nx1); const TrItemW ta = decode(2 * g_), tb = decode(2 * g_ + 1); TRW_LOAD(ta, r1a); TRW_LOAD(tb, r1b); }
#define TRW_ROUND(RA, RB) do {                                                                                                            \
        int t3 = 0; if (tid == 0) t3 = TRW_FETCH();                                                                                        \
        const int g_ = trw_ticket(list, cur); const TrItemW ta = decode(2 * g_), tb = decode(2 * g_ + 1);                                  \
        TRW_WRITE(T0, RA); TRW_WRITE(T1, RB);                                                                                              \
        if (nx2 < nl) { const int h_ = trw_ticket(list, nx2); const TrItemW na = decode(2 * h_), nb2 = decode(2 * h_ + 1); TRW_LOAD(na, RA); TRW_LOAD(nb2, RB); } \
        if (tid == 0) tick[0] = t3;                                                                                                        \
        __syncthreads();                                                                                                                   \
        TRW_OUT(T0, ta); TRW_OUT(T1, tb);                                                                                                  \
        const int n3 = __builtin_amdgcn_readfirstlane(tick[0]);                                                                            \
        __syncthreads();                                                                                                                   \
        cur = nx1; nx1 = nx2; nx2 = n3; } while (0)
    while (cur < nl) { TRW_ROUND(r0a, r0b); if (cur >= nl) break; TRW_ROUND(r1a, r1b); }
#undef TRW_ROUND
    asm volatile("s_waitcnt vmcnt(0)" ::: "memory"); __syncthreads();
#undef TRW_FETCH
#undef TRW_OUT
#undef TRW_WRITE
#undef TRW_LOAD
}

__device__ __forceinline__ void p0_adaln_task(const Args& a, LAS unsigned char* lds, int t, int tid, int wave, int lane) {
    LAS float* cond = (LAS float*)lds;
    LAS float* red = (LAS float*)(lds + 32768);
    const float* cin = a.in[1];
    for (int e = tid; e < BATCH * D; e += NWAVES * 64) { const int b = e / D, k = e - b * D; const float v = cin[e]; cond[k * 4 + b] = v / (1.0f + expf(-v)); }
    __syncthreads();
    const int i = t / 72, jc = t - i * 72, k0 = 256 * wave;
    const float* wp = a.in[4] + ((size_t)i * D + k0) * (9 * D) + jc * 256 + 4 * lane;
    f32x4 acc[4];
#pragma unroll
    for (int b = 0; b < 4; ++b) acc[b] = (f32x4){0.f, 0.f, 0.f, 0.f};
#pragma unroll 8
    for (int kk = 0; kk < 256; ++kk) { const f32x4 wv = __builtin_nontemporal_load((const GAS f32x4*)(wp + (size_t)kk * (9 * D))); const f32x4 cv = *(const LAS f32x4*)(cond + (k0 + kk) * 4);
#pragma unroll
        for (int b = 0; b < 4; ++b) acc[b] += cv[b] * wv; }
#pragma unroll
    for (int b = 0; b < 4; ++b) *(LAS f32x4*)(red + (wave * 4 + b) * 256 + 4 * lane) = acc[b];
    __syncthreads();
    float* coef = (float*)(a.ws + WS_COEF);
    for (int o = tid; o < 1024; o += NWAVES * 64) { const int b = o >> 8, cl = o & 255; float s = 0.f;
#pragma unroll
        for (int w = 0; w < 8; ++w) s += red[(w * 4 + b) * 256 + cl];
        const int col = jc * 256 + cl, sub = col / (3 * D), kind = (col / D) % 3, d = col % D;
        float v = s + a.in[5][i * 9 * D + col];
        if (kind == 1) v = a.in[3][(i * 3 + sub) * D + d] * (1.0f + v);
        if (kind == 2 && sub != 1) v *= 0.5f;
        coef[((size_t)((i * 3 + sub) * 3 + kind) * 4 + b) * D + d] = v; }
    __syncthreads();
}

__device__ __forceinline__ void ssm_disc(const Args& a, int g, int n, float& abr, float& abi, float& cfr, float& cfi) {
    const float dt = expf(a.in[16][g]), ar = a.in[14][g * SST + n], ai = a.in[15][g * SST + n];
    const float mag = expf(dt * ar); abr = mag * cosf(dt * ai); abi = mag * sinf(dt * ai);
    const float den = ar * ar + ai * ai, nre = abr - 1.0f;
    cfr = (nre * ar + abi * ai) / den; cfi = (abi * ar - nre * ai) / den;
}
__device__ __forceinline__ void p0_ssm_task(const Args& a, LAS unsigned char* lds, int g, int tid) {
    LAS float* pwr = (LAS float*)lds;
    LAS float* pwi = pwr + 17 * 64;
    LAS float* bbr = pwi + 17 * 64;
    LAS float* bbi = bbr + 1024;
    LAS float* ccr = bbi + 1024;
    LAS float* cci = ccr + 1024;
    LAS float* cfs = cci + 1024;
    LAS float* Kt = cfs + 128;
    if (tid < SST) { float abr, abi, cfr, cfi; ssm_disc(a, g, tid, abr, abi, cfr, cfi); cfs[tid * 2] = cfr; cfs[tid * 2 + 1] = cfi;
        float pr = 1.f, pi = 0.f;
        for (int l = 0; l <= 16; ++l) { pwr[l * 64 + tid] = pr; pwi[l * 64 + tid] = pi; const float nr = pr * abr - pi * abi, ni = pr * abi + pi * abr; pr = nr; pi = ni; } }
    __syncthreads();
    for (int e = tid; e < 1024; e += NWAVES * 64) { const int n = e >> 4; const float br = a.in[17][(size_t)g * 1024 + e], bi = a.in[18][(size_t)g * 1024 + e], cr = cfs[n * 2], ci = cfs[n * 2 + 1];
        bbr[e] = cr * br - ci * bi; bbi[e] = cr * bi + ci * br; ccr[e] = a.in[19][(size_t)g * 1024 + e]; cci[e] = a.in[20][(size_t)g * 1024 + e]; }
    __syncthreads();
    { const int pq = tid & 255, p = pq >> 4, q = pq & 15, l0 = (tid >> 8) * 8;
        float s[8];
#pragma unroll
        for (int j = 0; j < 8; ++j) s[j] = 0.f;
        for (int n = 0; n < SST; ++n) { const float cr = ccr[p * 64 + n], ci = cci[p * 64 + n], br = bbr[n * 16 + q], bi = bbi[n * 16 + q];
            const float er = cr * br - ci * bi, ei = cr * bi + ci * br;
#pragma unroll
            for (int j = 0; j < 8; ++j) s[j] += er * pwr[(l0 + j) * 64 + n] - ei * pwi[(l0 + j) * 64 + n]; }
        if (l0 == 0 && p == q) s[0] += a.in[21][g * SGRP + p];
#pragma unroll
        for (int j = 0; j < 8; ++j) Kt[(l0 + j) * 256 + pq] = s[j]; }
    __syncthreads();
    bf16* TV = (bf16*)(a.ws + WS_TV) + (size_t)g * 256 * SLD;
    for (int ch = tid; ch < 256 * 48; ch += NWAVES * 64) { const int row = ch / 48, kc = ch - row * 48, t = row >> 4, p = row & 15; float v[8];
        if (kc < 32) { const int tp = kc >> 1, q0 = 8 * (kc & 1);
#pragma unroll
            for (int e = 0; e < 8; ++e) v[e] = tp <= t ? Kt[((t - tp) * 16 + p) * 16 + q0 + e] : 0.f; }
        else { const int n20 = 8 * (kc - 32);
#pragma unroll
            for (int e = 0; e < 8; ++e) { const int n2 = n20 + e, n = n2 & 63; const float cr = ccr[p * 64 + n], ci = cci[p * 64 + n], pr = pwr[(t + 1) * 64 + n], pi = pwi[(t + 1) * 64 + n];
                v[e] = n2 < 64 ? (cr * pr - ci * pi) : -(cr * pi + ci * pr); } }
        v4u o; o.x = pk2(v[0], v[1]); o.y = pk2(v[2], v[3]); o.z = pk2(v[4], v[5]); o.w = pk2(v[6], v[7]);
        *(GAS v4u*)(TV + (size_t)row * SLD + 8 * kc) = o; }
    bf16* SW = (bf16*)(a.ws + WS_SW) + (size_t)g * 256 * 256;
    for (int ch = tid; ch < 256 * 32; ch += NWAVES * 64) { const int n2 = ch >> 5, kc = ch & 31, tp = kc >> 1, q0 = 8 * (kc & 1), n = n2 & 63; float v[8];
#pragma unroll
        for (int e = 0; e < 8; ++e) { const float pr = pwr[(15 - tp) * 64 + n], pi = pwi[(15 - tp) * 64 + n], br = bbr[n * 16 + q0 + e], bi = bbi[n * 16 + q0 + e];
            v[e] = n2 < 64 ? (pr * br - pi * bi) : (n2 < 128 ? (pr * bi + pi * br) : 0.f); }
        v4u o; o.x = pk2(v[0], v[1]); o.y = pk2(v[2], v[3]); o.z = pk2(v[4], v[5]); o.w = pk2(v[6], v[7]);
        *(GAS v4u*)(SW + (size_t)n2 * 256 + 8 * kc) = o; }
    __syncthreads();
}
__device__ __forceinline__ void p0_rope(const Args& a, int gtid, int ngt) {
    const int* pos = (const int*)a.in[2]; float* rope = (float*)(a.ws + WS_ROPE);
    for (int e = gtid; e < M * 16; e += ngt) { const int m = e >> 4, j = e & 15;
        const float inv = powf(500000.0f, -(float)j * (1.0f / 16.0f)), ang = (float)pos[m] * inv;
        rope[m * 32 + j] = cosf(ang); rope[m * 32 + 16 + j] = sinf(ang); }
}

typedef _Float16 f16x4v __attribute__((ext_vector_type(4)));
__device__ __forceinline__ f32x4 ldx4(const float* row, int i) { return *((const GAS f32x4*)row + i); }
__device__ __forceinline__ f32x4 ldx4(const _Float16* row, int i) { const f16x4v h = *((const GAS f16x4v*)row + i); return (f32x4){(float)h[0], (float)h[1], (float)h[2], (float)h[3]}; }
template <bool SSM, class XT>
__device__ __forceinline__ void norm_phase(const XT* x, const float* gs  , const float* sh, bf16* dst, int gw, int ngw, int lane) {
    for (int rb = gw; rb < M / 8; rb += ngw) {
        const int r0 = rb * 8, b = r0 / SEQ;
        f32x4 g4[8], s4[8];
#pragma unroll
        for (int j = 0; j < 8; ++j) { g4[j] = *((const GAS f32x4*)(gs + (size_t)b * D) + lane + 64 * j); s4[j] = *((const GAS f32x4*)(sh + (size_t)b * D) + lane + 64 * j); }
        for (int rr = 0; rr < 8; ++rr) {
            const int m = r0 + rr; const XT* xr = x + (size_t)m * D;
            f32x4 v[8]; float ss = 0.f;
#pragma unroll
            for (int j = 0; j < 8; ++j) { v[j] = ldx4(xr, lane + 64 * j); ss += (v[j].x * v[j].x + v[j].y * v[j].y) + (v[j].z * v[j].z + v[j].w * v[j].w); }
            const float rs = 1.0f / sqrtf(wave_sum(ss) * (1.0f / D) + NORM_EPS);
#pragma unroll
            for (int j = 0; j < 8; ++j) { const f32x4 h = v[j] * rs * g4[j] + s4[j]; v2u o; o.x = pk2(h.x, h.y); o.y = pk2(h.z, h.w);
                if (SSM) { const int s = m - b * SEQ, c = s >> 4, tau = s & 15, g = (lane + 64 * j) >> 2, q0 = 4 * (lane & 3);
                    *(GAS v2u*)(dst + ((size_t)((g * BATCH + b) * NCH + c)) * SLD + tau * 16 + q0) = o; }
                else *((GAS v2u*)(dst + (size_t)m * KP) + lane + 64 * j) = o; }
        }
    }
}
__device__ __forceinline__ void combine_phase(const Args& a, int gw, int ngw, int lane) {
    const bf16* OH = (const bf16*)(a.ws + WS_OH); bf16* HA = (bf16*)(a.ws + WS_HA);
    const float* lv = a.in[12];
    const float l1 = wave_sum(lv[lane] * lv[128 + lane] + lv[64 + lane] * lv[192 + lane]), l2 = wave_sum(lv[256 + lane] * lv[384 + lane] + lv[320 + lane] * lv[448 + lane]);
    const float lam = expf(l1) - expf(l2) + 0.2f;
    const int vh = lane >> 5, d = 4 * (lane & 31);
    float sg[4];
#pragma unroll
    for (int e = 0; e < 4; ++e) sg[e] = a.in[13][4 * lane + e] * 0.8f;
    for (int m = gw; m < M; m += ngw) {
        const int b = m / SEQ, s = m - b * SEQ;
#pragma unroll
        for (int h = 0; h < NH; ++h) {
            const size_t base0 = ((size_t)(((b * NH + h) * 2 + 0) * 2 + vh) * SEQ + s) * HD + d, base1 = ((size_t)(((b * NH + h) * 2 + 1) * 2 + vh) * SEQ + s) * HD + d;
            const v2u w0 = *(const GAS v2u*)(OH + base0), w1 = *(const GAS v2u*)(OH + base1);
            float df[4] = {bf_lo(w0.x) - lam * bf_lo(w1.x), bf_hi(w0.x) - lam * bf_hi(w1.x), bf_lo(w0.y) - lam * bf_lo(w1.y), bf_hi(w0.y) - lam * bf_hi(w1.y)};
            const float ss = wave_sum(df[0] * df[0] + df[1] * df[1] + df[2] * df[2] + df[3] * df[3]);
            const float rs = 1.0f / sqrtf(ss * (1.0f / VD) + NORM_EPS);
            v2u o; o.x = pk2(df[0] * rs * sg[0], df[1] * rs * sg[1]); o.y = pk2(df[2] * rs * sg[2], df[3] * rs * sg[3]);
            *(GAS v2u*)(HA + (size_t)m * KP + h * VD + 4 * lane) = o;
        }
    }
}
__device__ __forceinline__ void scan_phase(const Args& a, LAS unsigned char* lds, int bx, int G, int tid) {
    const float* SL = (const float*)(a.ws + WS_SLOC); bf16* HS = (bf16*)(a.ws + WS_HS2);
    LAS float* tot = (LAS float*)lds;
    const int seg = tid >> 6, n = tid & 63;
    pg8::StaticOrder SO; SO.init(SROWS, 256, G, bx); pg8::Unit un;
    for (int ui = 0; SO.next(ui, un); ++ui) { const int u = un.pm;
        const int g = u >> 2;
        float abr, abi, cfr, cfi; ssm_disc(a, g, n, abr, abi, cfr, cfi);
        float a16r = abr, a16i = abi;
#pragma unroll
        for (int i = 0; i < 4; ++i) { const float nr = a16r * a16r - a16i * a16i, ni = 2.f * a16r * a16i; a16r = nr; a16i = ni; }
        float a512r = a16r, a512i = a16i;
#pragma unroll
        for (int i = 0; i < 5; ++i) { const float nr = a512r * a512r - a512i * a512i, ni = 2.f * a512r * a512i; a512r = nr; a512i = ni; }
        const size_t R0 = (size_t)u * NCH + seg * 32;
        float vr[32], vi[32];
#pragma unroll
        for (int j = 0; j < 32; ++j) { vr[j] = SL[(R0 + j) * 128 + n]; vi[j] = SL[(R0 + j) * 128 + 64 + n]; }
        float tr = 0.f, ti = 0.f;
#pragma unroll
        for (int j = 0; j < 32; ++j) { const float nr = a16r * tr - a16i * ti + vr[j], ni = a16r * ti + a16i * tr + vi[j]; tr = nr; ti = ni; }
        tot[(seg * 64 + n) * 2] = tr; tot[(seg * 64 + n) * 2 + 1] = ti;
        __syncthreads();
        float cr = 0.f, ci = 0.f;
        for (int s2 = 0; s2 < seg; ++s2) { const float nr = a512r * cr - a512i * ci + tot[(s2 * 64 + n) * 2], ni = a512r * ci + a512i * cr + tot[(s2 * 64 + n) * 2 + 1]; cr = nr; ci = ni; }
#pragma unroll
        for (int j = 0; j < 32; ++j) { bf16* dst = HS + (R0 + j) * SLD + 256 + n; dst[0] = (bf16)f2bf(cr); dst[64] = (bf16)f2bf(ci);
            const float nr = a16r * cr - a16i * ci + vr[j], ni = a16r * ci + a16i * cr + vi[j]; cr = nr; ci = ni; }
        __syncthreads();
    }
}
__device__ __forceinline__ void attn_phase(const Args& a, char* lds, int bx, int G) {
    typedef att::BlockRef<att::TIN, att::TOUT> Ref;
    const att::TIN* QH = (const att::TIN*)(a.ws + WS_QH); const att::TIN* KH = (const att::TIN*)(a.ws + WS_KH); const att::TIN* VH = (const att::TIN*)(a.ws + WS_VH); att::TOUT* OH = (att::TOUT*)(a.ws + WS_OH);
    constexpr int TOTAL = BATCH * NH * 4 * 8; constexpr size_t HS_ = (size_t)SEQ * HD;
    int L = bx; if (L >= TOTAL) return;
    int pass = 0;
#define ATT_REF(r, L_, pass_) do { const int xcd_ = (L_) & 7, k_ = (L_) >> 3, bhv = xcd_ * 16 + (k_ >> 5) * 4 + ((k_ >> 3) & 3), x = k_ & 7, qb = (pass_) ? 15 - x : x; \
        r.Q = QH + (size_t)(bhv >> 1) * HS_ + (size_t)qb * att::QB * HD; r.K = KH + (size_t)(bhv >> 1) * HS_; r.V = VH + (size_t)(((bhv >> 2) << 1) | (bhv & 1)) * HS_; \
        r.O = OH + (size_t)bhv * HS_ + (size_t)qb * att::QB * HD; r.P0 = qb * att::QB; } while (0)
    Ref cur; ATT_REF(cur, L, 0);
    att::Seam<att::TIN> S;
    att::causal_swa_prime<att::TIN, att::TOUT>(cur, att::WINDOW, lds, S);
    for (;;) {
        const bool more_pass = pass == 0, more_item = L + G < TOTAL, last = !more_pass && !more_item;
        int passn = pass + 1, Ln = L;
        if (!more_pass) { passn = 0; Ln = more_item ? L + G : L; }
        Ref nxt = cur; if (!last) ATT_REF(nxt, Ln, passn);
        att::causal_swa_block<att::TIN, att::TOUT>(cur, nxt, SEQ, att::WINDOW, lds, S);
        if (last) break;
        cur = nxt; pass = passn; L = Ln;
    }
#undef ATT_REF
}

namespace att {
struct RsaRef { const bf16* Q; const bf16* K; const bf16* V0; const bf16* V1; bf16* O; int P0; };
__device__ __forceinline__ void pv2_tile(f32x16* o, int vb, bf16x8 pa0, bf16x8 pa1, bf16x8 pa2, bf16x8 pa3) {
#define TRRD(dst, off) asm volatile("ds_read_b64_tr_b16 %0, %1 offset:%2" : "=&v"(dst) : "v"(vb), "i"(off) : "memory")
#define PV2_RD(F, blk) do { constexpr int b_ = ((blk) >> 2) * 16384 + ((blk) & 3) * 512; \
        TRRD(F[0], b_); TRRD(F[1], b_ + 2048); TRRD(F[2], b_ + 4096); TRRD(F[3], b_ + 6144); TRRD(F[4], b_ + 8192); TRRD(F[5], b_ + 10240); TRRD(F[6], b_ + 12288); TRRD(F[7], b_ + 14336); } while (0)
#define PV2_MM(F, blk) do { \
        o[blk] = __builtin_amdgcn_mfma_f32_32x32x16_bf16(pa0, (bf16x8){F[0][0], F[0][1], F[0][2], F[0][3], F[1][0], F[1][1], F[1][2], F[1][3]}, o[blk], 0, 0, 0); \
        o[blk] = __builtin_amdgcn_mfma_f32_32x32x16_bf16(pa1, (bf16x8){F[2][0], F[2][1], F[2][2], F[2][3], F[3][0], F[3][1], F[3][2], F[3][3]}, o[blk], 0, 0, 0); \
        o[blk] = __builtin_amdgcn_mfma_f32_32x32x16_bf16(pa2, (bf16x8){F[4][0], F[4][1], F[4][2], F[4][3], F[5][0], F[5][1], F[5][2], F[5][3]}, o[blk], 0, 0, 0); \
        o[blk] = __builtin_amdgcn_mfma_f32_32x32x16_bf16(pa3, (bf16x8){F[6][0], F[6][1], F[6][2], F[6][3], F[7][0], F[7][1], F[7][2], F[7][3]}, o[blk], 0, 0, 0); } while (0)
#define PV2_W8() do { asm volatile("s_waitcnt lgkmcnt(8)" ::: "memory"); SBAR(); } while (0)
#define PV2_W0() do { asm volatile("s_waitcnt lgkmcnt(0)" ::: "memory"); SBAR(); } while (0)
    s16x4 fa[8], fb[8];
    asm volatile("s_waitcnt lgkmcnt(0)" : "+v"(pa0), "+v"(pa1), "+v"(pa2), "+v"(pa3) :: "memory"); SBAR();
    PV2_RD(fa, 0);
    PV2_RD(fb, 1); PV2_W8(); PV2_MM(fa, 0); SBAR();
    PV2_RD(fa, 2); PV2_W8(); PV2_MM(fb, 1); SBAR();
    PV2_RD(fb, 3); PV2_W8(); PV2_MM(fa, 2); SBAR();
    PV2_RD(fa, 4); PV2_W8(); PV2_MM(fb, 3); SBAR();
    PV2_RD(fb, 5); PV2_W8(); PV2_MM(fa, 4); SBAR();
    PV2_RD(fa, 6); PV2_W8(); PV2_MM(fb, 5); SBAR();
    PV2_RD(fb, 7); PV2_W8(); PV2_MM(fa, 6); SBAR();
    PV2_W0(); PV2_MM(fb, 7); SBAR();
#undef PV2_W0
#undef PV2_W8
#undef PV2_MM
#undef PV2_RD
#undef TRRD
}
__device__ __forceinline__ void rsa_block(const RsaRef& R, char* lds, char* stats) {
    const int tid = ptid(), wid = __builtin_amdgcn_readfirstlane(tid >> 6), lane = tid & 63, r32 = lane & 31, hi = lane >> 5;
    const bool prod = wid < 4; const int pi = wid & 3;
    const int NT = (R.P0 + 127) / KVBLK + 1;
    const int tr = tid & 255, sr = tr >> 4, sc = (tr & 15) * 8, kws = KSWZ(sr, sc * 2), vst = v_st(sr, sc);
    char* Kl = lds; char* Vl = lds + 32768; char* Pl = lds + 98304 + pi * 8192;
    float* Al = (float*)stats + pi * 192;
    const int qlo = R.P0 + pi * QBLK, qm = qlo + r32 - 4 * hi;
#define RSA_LD4(dst, S_, o_, P_, k0) do { _Pragma("unroll") for (int j_ = 0; j_ < 4; ++j_) dst[S_][(o_) + j_] = load8<bf16>((P_) + (size_t)((k0) + sr + 16 * j_) * D + sc); } while (0)
#define RSA_WR4(src, S_, o_, base_, off_) do { _Pragma("unroll") for (int j_ = 0; j_ < 4; ++j_) *(bf16x8*)((base_) + (off_) + 4096 * j_) = src[S_][(o_) + j_]; } while (0)
    if (prod) {
        bf16x8 st[2][8];
#define RSA_LOAD(S_, k0) do { RSA_LD4(st, S_, 0, R.K, k0); RSA_LD4(st, S_, 4, R.V0, k0); } while (0)
#define RSA_WRITE(b, S_) do { RSA_WR4(st, S_, 0, Kl + (b) * 16384, kws); RSA_WR4(st, S_, 4, Vl + ((b) * 2) * 16384, vst); } while (0)
#define RSA_STAGE_A(t_, B_) do { if ((t_) + 2 < NT) RSA_LOAD(B_, ((t_) + 2) * KVBLK); } while (0)
#define RSA_STAGE_B(t_, B_) do { __syncthreads(); if ((t_) + 1 < NT) { if ((t_) + 2 < NT) asm volatile("s_waitcnt vmcnt(8)" ::: "memory"); else asm volatile("s_waitcnt vmcnt(0)" ::: "memory"); RSA_WRITE(1 - (B_), 1 - (B_)); } __syncthreads(); } while (0)
        RSA_LOAD(0, 0);
        asm volatile("s_waitcnt vmcnt(0)" ::: "memory"); RSA_WRITE(0, 0);
        if (NT > 1) RSA_LOAD(1, KVBLK);
        bf16x8 qr[8];
#pragma unroll
        for (int d0 = 0; d0 < 8; ++d0) qr[d0] = load8<bf16>(R.Q + (size_t)(pi * QBLK + r32) * D + d0 * 16 + hi * 8);
        __syncthreads();
        float m_reg = -1e30f, l_reg = 0.f;
#define RSA_PROD(T_, B_) do { const int t_ = (T_); RSA_STAGE_A(t_, B_); \
            if (t_ < NT) { f32x16 p0, p1; float mn, al; bf16x8 pa0, pa1, pa2, pa3; \
                qkt<0, false>(p0, p1, Kl + (B_) * 16384, r32, hi, qr, true); \
                { const int kb_ = t_ * KVBLK; if (kb_ + KVBLK - 1 > qlo) mask_tile(p0, p1, qm - kb_, (unsigned)WINDOW); } \
                partialSM(p0, p1, m_reg, mn, al); finishSM(p0, p1, al, l_reg, pa0, pa1, pa2, pa3); \
                bf16x8* pw = (bf16x8*)(Pl + (B_) * 4096 + lane * 64); pw[0] = pa0; pw[1] = pa1; pw[2] = pa2; pw[3] = pa3; \
                { const bool any_ = __any(al < 1.f); if (hi == 0) Al[(B_) * 64 + r32] = al; if (lane == 0) Al[(B_) * 64 + 32] = any_ ? 1.f : 0.f; } } \
            RSA_STAGE_B(t_, B_); } while (0)
        for (int t = 0; t <= NT; t += 2) { RSA_PROD(t, 0); if (t + 1 <= NT) RSA_PROD(t + 1, 1); }
#undef RSA_PROD
#undef RSA_LOAD
#undef RSA_WRITE
#undef RSA_STAGE_A
#undef RSA_STAGE_B
        if (hi == 0) Al[128 + r32] = l_reg;
        __syncthreads();
    } else {
        bf16x8 st[2][4];
#define RSA_LOAD(S_, k0) do { RSA_LD4(st, S_, 0, R.V1, k0); } while (0)
#define RSA_WRITE(b, S_) do { RSA_WR4(st, S_, 0, Vl + ((b) * 2 + 1) * 16384, vst); } while (0)
#define RSA_STAGE_A(t_, B_) do { if ((t_) + 2 < NT) RSA_LOAD(B_, ((t_) + 2) * KVBLK); } while (0)
#define RSA_STAGE_B(t_, B_) do { __syncthreads(); if ((t_) + 1 < NT) { if ((t_) + 2 < NT) asm volatile("s_waitcnt vmcnt(4)" ::: "memory"); else asm volatile("s_waitcnt vmcnt(0)" ::: "memory"); RSA_WRITE(1 - (B_), 1 - (B_)); } __syncthreads(); } while (0)
        RSA_LOAD(0, 0);
        asm volatile("s_waitcnt vmcnt(0)" ::: "memory"); RSA_WRITE(0, 0);
        if (NT > 1) RSA_LOAD(1, KVBLK);
        __syncthreads();
        f32x16 o[8];
#pragma unroll
        for (int d = 0; d < 8; ++d) o[d] = f32x16{};
        const int vbase = (int)(uintptr_t)Vl + v_rd_base(lane);
#define RSA_CONS(T_, B_) do { const int t_ = (T_); RSA_STAGE_A(t_, B_); \
            if (t_ >= 1) { const bf16x8* pr = (const bf16x8*)(Pl + (1 - (B_)) * 4096 + lane * 64); const bf16x8 pa0 = pr[0], pa1 = pr[1], pa2 = pr[2], pa3 = pr[3]; \
                if (Al[(1 - (B_)) * 64 + 32] != 0.f) { _Pragma("unroll") for (int r = 0; r < 16; ++r) { const float a_ = Al[(1 - (B_)) * 64 + crow(r, hi)]; _Pragma("unroll") for (int d = 0; d < 8; ++d) o[d][r] *= a_; } } \
                pv2_tile(o, vbase + ((1 - (B_)) * 2) * 16384, pa0, pa1, pa2, pa3); } \
            RSA_STAGE_B(t_, B_); } while (0)
        for (int t = 0; t <= NT; t += 2) { RSA_CONS(t, 0); if (t + 1 <= NT) RSA_CONS(t + 1, 1); }
#undef RSA_CONS
        __syncthreads();
        float rli[16];
#pragma unroll
        for (int r = 0; r < 16; ++r) rli[r] = __builtin_amdgcn_rcpf(Al[128 + crow(r, hi)]);
        bf16* Ow = R.O + (size_t)(pi * QBLK) * 256;
#pragma unroll
        for (int r = 0; r < 16; ++r) { const int orow = crow(r, hi);
#pragma unroll
            for (int d0 = 0; d0 < 8; ++d0) { const float v = o[d0][r] * rli[r]; const float vn = __shfl_xor(v, 1);
                if ((r32 & 1) == 0) *(unsigned*)(Ow + (size_t)orow * 256 + d0 * 32 + r32) = cvtpk(v, vn); } }
    }
    __syncthreads();
#undef RSA_STAGE_A
#undef RSA_STAGE_B
#undef RSA_LOAD
#undef RSA_WRITE
#undef RSA_LD4
#undef RSA_WR4
}
}
__device__ __forceinline__ void attn_phase_rsa(const Args& a, char* lds, LAS unsigned char* lds_l, int bx, int G, int pm = 0) {
    const att::bf16* QH = (const att::bf16*)(a.ws + WS_QH); const att::bf16* KH = (const att::bf16*)(a.ws + WS_KH); const att::bf16* VH = (const att::bf16*)(a.ws + WS_VH); att::bf16* OH = (att::bf16*)(a.ws + (pm ? WS_ACT : WS_OH));
    constexpr int TOTAL = BATCH * NH * 2 * 16; constexpr size_t HS_ = (size_t)SEQ * HD;
    for (int L = bx; L < TOTAL; L += G) {
        const int xcd = L & 7, k_ = L >> 3, bhc = xcd * 8 + (k_ >> 4), x = k_ & 15, bh = bhc >> 1;
#pragma unroll 1
        for (int pass = 0; pass < 2; ++pass) { const int qb = pass ? 31 - x : x;
            att::RsaRef R; R.Q = QH + (size_t)bhc * HS_ + (size_t)qb * 128 * HD; R.K = KH + (size_t)bhc * HS_; R.V0 = VH + (size_t)(bh * 2) * HS_; R.V1 = VH + (size_t)(bh * 2 + 1) * HS_;
            R.O = OH + ((size_t)bhc * SEQ + (size_t)qb * 128) * 256; R.P0 = qb * 128;
#if ATT_SKA
            att::SkaRef K_; K_.Q = R.Q; K_.K = R.K; K_.V0 = R.V0; K_.V1 = R.V1; K_.O = R.O; K_.P0 = R.P0; K_.pm = pm;
            att::ska_block(K_, lds, (LAS unsigned char*)lds_l);
#else
            att::rsa_block(R, lds, lds + RING_BYTES + 1024);
#endif
        }
    }
}
__device__ __forceinline__ void attn_phase_wva(const Args& a, char* lds, LAS unsigned char* lds_l, int bx, int G, int lane) {
    const att::bf16* QH = (const att::bf16*)(a.ws + WS_QH); const att::bf16* KH = (const att::bf16*)(a.ws + WS_KH); const att::bf16* VH = (const att::bf16*)(a.ws + WS_VH); att::bf16* OH = (att::bf16*)(a.ws + WS_OH);
    att::bf16* HA = (att::bf16*)(a.ws + WS_HA);
    const float* lv = a.in[12];
    const float l1 = wave_sum(lv[lane] * lv[128 + lane] + lv[64 + lane] * lv[192 + lane]), l2 = wave_sum(lv[256 + lane] * lv[384 + lane] + lv[320 + lane] * lv[448 + lane]);
    const float lam = expf(l1) - expf(l2) + 0.2f;
    constexpr int TOTAL = BATCH * NH * 8; constexpr size_t HS_ = (size_t)SEQ * HD;
    for (int L = bx; L < TOTAL; L += G) {
        const int xcd = L & 7, k_ = L >> 3, bh = xcd * 4 + (k_ >> 3), x = k_ & 7, b = bh / NH, h = bh - b * NH;
#pragma unroll 1
        for (int pass = 0; pass < 4; ++pass) { const int qb = (pass >> 1) ? x : 15 - x, c = pass & 1, bhc = bh * 2 + c;
            att::SkaRef R; R.Q = QH + (size_t)bhc * HS_ + (size_t)qb * 256 * HD; R.K = KH + (size_t)bhc * HS_; R.V0 = VH + (size_t)(bh * 2) * HS_; R.V1 = VH + (size_t)(bh * 2 + 1) * HS_;
            R.O = OH + ((size_t)(bh * 2) * SEQ + (size_t)qb * 256) * 256; R.P0 = qb * 256; R.pm = 0;
            att::wva_block(R, lds, lds_l, c, lam, a.in[13], HA + ((size_t)b * SEQ + (size_t)qb * 256) * KP + h * VD, KP); }
    }
}
__device__ __forceinline__ void combine_phase_rsa(const Args& a, int gw, int ngw, int lane) {
    const bf16* OH = (const bf16*)(a.ws + WS_OH); bf16* HA = (bf16*)(a.ws + WS_HA);
    const float* lv = a.in[12];
    const float l1 = wave_sum(lv[lane] * lv[128 + lane] + lv[64 + lane] * lv[192 + lane]), l2 = wave_sum(lv[256 + lane] * lv[384 + lane] + lv[320 + lane] * lv[448 + lane]);
    const float lam = expf(l1) - expf(l2) + 0.2f;
    float sg[4];
#pragma unroll
    for (int e = 0; e < 4; ++e) sg[e] = a.in[13][4 * lane + e] * 0.8f;
    for (int m = gw; m < M; m += ngw) {
        const int b = m / SEQ, s = m - b * SEQ;
#pragma unroll
        for (int h = 0; h < NH; ++h) {
            const size_t base0 = ((size_t)((b * NH + h) * 2 + 0) * SEQ + s) * VD + 4 * lane, base1 = ((size_t)((b * NH + h) * 2 + 1) * SEQ + s) * VD + 4 * lane;
            const v2u w0 = *(const GAS v2u*)(OH + base0), w1 = *(const GAS v2u*)(OH + base1);
            float df[4] = {bf_lo(w0.x) - lam * bf_lo(w1.x), bf_hi(w0.x) - lam * bf_hi(w1.x), bf_lo(w0.y) - lam * bf_lo(w1.y), bf_hi(w0.y) - lam * bf_hi(w1.y)};
            const float ss = wave_sum(df[0] * df[0] + df[1] * df[1] + df[2] * df[2] + df[3] * df[3]);
            const float rs = 1.0f / sqrtf(ss * (1.0f / VD) + NORM_EPS);
            v2u o; o.x = pk2(df[0] * rs * sg[0], df[1] * rs * sg[1]); o.y = pk2(df[2] * rs * sg[2], df[3] * rs * sg[3]);
            *(GAS v2u*)(HA + (size_t)m * KP + h * VD + 4 * lane) = o;
        }
    }
}

__global__ void __launch_bounds__(NWAVES * 64, 2) mk_fwd(Args args) {
    extern __shared__ __attribute__((aligned(16))) unsigned char lds_raw[];
    LAS unsigned char* lds = (LAS unsigned char*)lds_raw;
    volatile LAS unsigned* MISC = (volatile LAS unsigned*)(lds + MISC_OFF);
    const int G = gridDim.x, bx = blockIdx.x, ngw = G * NWAVES;
    unsigned char* ws = args.ws;
    gu32* ctl = (gu32*)(ws + WS_CTL);
    { const int tid0 = ptid(); for (int u = tid0; u < (LDS_BYTES - LDSCTL_OFF) / 4; u += NWAVES * 64) ((LAS unsigned*)(lds + LDSCTL_OFF))[u] = 0u; }
    __syncthreads();
#define PHASE_IDS const int tid = ptid(), lane = tid & 63, wave = __builtin_amdgcn_readfirstlane(tid >> 6), gw = bx * NWAVES + wave; (void)tid; (void)lane; (void)gw
    const int lo = args.ph_lo, hi = args.ph_hi;
    XcdBarrier bar; bar.bar = (unsigned*)(ctl + CW_BAR); bar.x = 0; bar.st = nullptr;
    if (hi - lo > 1) bar = xcd_barrier_post((unsigned*)(ctl + CW_BAR), MISC + 8);
#define IN(k) (PH_EN(k) && lo <= (k) && (k) < hi)
#define SEAM(k) do { if (IN(k) && IN((k) + 1)) { xcd_barrier(bar); if (PROBE_DUP == 300) { xcd_barrier(bar); xcd_barrier(bar); } if (PROBE_DUP == 400) { for (int i_ = 0; i_ < 5; ++i_) __builtin_amdgcn_s_sleep(127); } } } while (0)
    const float* coef = (const float*)(ws + WS_COEF);
#define COEF(i, sub, kind) (coef + (size_t)(((i) * 3 + (sub)) * 3 + (kind)) * 4 * D)
    bf16* HA = (bf16*)(ws + WS_HA); bf16* ACT = (bf16*)(ws + WS_ACT);
    const bool fz = FUSE_NORM != 0 && G == 256;
    const float* xin = args.in[0]; float* xo = args.out; _Float16* xh = (_Float16*)(ws + WS_XH);

    if (IN(0)) for (int rep = 0; rep < NREP(0); ++rep) { PHASE_IDS;
        for (int t = bx; t < 144; t += G) p0_adaln_task(args, lds, t, tid, wave, lane);
        for (int t = G - 1 - bx; t < NGRP; t += G) p0_ssm_task(args, lds, t, tid);
        p0_rope(args, bx * NWAVES * 64 + tid, G * NWAVES * 64);
#if PROBE_XNAN
        for (size_t e = (size_t)bx * NWAVES * 64 + tid; e < (size_t)3 * MiB / 4; e += (size_t)G * NWAVES * 64) ((unsigned*)(ws + WS_XBUF))[e] = 0x7fc00000u;
#endif
#if DEFER_W
        p0_transposes_wg(args, lds, tid, wave, lane, (unsigned*)(ctl + CW_Q), 0, TRW_N0, 1 << 30);
#else
        p0_transposes(args, lds, gw, ngw, wave, lane);
#endif
        if (NREP(0) > 1) __syncthreads();
    }
    SEAM(0);
#define FFN_PHASES(P, F, LI, SUB, XSRC, XDST, XI16, XO16, NRM, FN, NLI, NSUB, INST, FSSM) \
    if ((NRM) || !fz) { if (IN(P)) for (int rep = 0; rep < NREP(P); ++rep) { PHASE_IDS; norm_phase<false>(XSRC, COEF(LI, SUB, 1), COEF(LI, SUB, 0), HA, gw, ngw, lane); } \
    SEAM(P); } \
    if (IN((P) + 1)) for (int rep = 0; rep < NREP((P) + 1); ++rep) { pg8::Gemm g{HA, (const bf16*)(ws + WS_WIN) + (size_t)(F) * 2 * FF * KP, M, 2 * FF, D, KP, KP, 0}; pg8::StaticOrder S; S.init(M, 2 * FF, G, bx, G1_WGM); S.mrev = G1_MREV; S.nrev = G1_NREV; \
        pg8::EpiSwiGLU E{ACT, FP}; \
        if (DEFER_W && (P) == 1) { PHASE_IDS; const int ks_ = (bx & 7) + 1;     \
            S.i1 = ks_; pg8::gemm_phase<pg8::EpiSwiGLU>(lds, g, S, E); p0_transposes_wg(args, lds, tid, wave, lane, (unsigned*)(ctl + CW_Q) + 64, 1, TRW_N1, DEFER_QUOTA); S.i0 = ks_; S.i1 = 1 << 30; } \
        if (G1_SPLIT) { S.i1 = G1_SPLIT; pg8::gemm_phase<pg8::EpiSwiGLU>(lds, g, S, E); xcd_barrier(bar); S.i0 = G1_SPLIT; S.i1 = 1 << 30; } \
        pg8::gemm_phase<pg8::EpiSwiGLU>(lds, g, S, E); \
        if (DEFER_W && (P) == 1) { PHASE_IDS; p0_transposes_wg(args, lds, tid, wave, lane, (unsigned*)(ctl + CW_Q) + 64, 1, TRW_N1, 1 << 30); }     \
        } \
    if (IN((P) + 1) && PROBE_DUP == 100 + (P) + 1) { pg8::Gemm g{HA, (const bf16*)(ws + WS_WIN) + (size_t)(F) * 2 * FF * KP, M, 2 * FF, D, KP, KP, 0}; pg8::StaticOrder S; S.init(M, 2 * FF, G, bx); \
        pg8::EpiNull E{}; pg8::gemm_phase<pg8::EpiNull>(lds, g, S, E); } \
    SEAM((P) + 1); \
    if (IN((P) + 2)) for (int rep = 0; rep < NREP((P) + 2); ++rep) { pg8::Gemm g{ACT, (const bf16*)(ws + WS_WOUT) + (size_t)(F) * D * FP, M, D, FF, FP, FP, 0, G2_KREV}; pg8::StaticOrder S; S.init(M, D, G, bx, G2_WGM); S.mrev = G2_MREV; \
        if ((FN) && fz) { pg8::EpiResidN<XI16, FSSM> E{XSRC, (_Float16*)xh, D, COEF(LI, SUB, 2), SEQ / 256, COEF(NLI, NSUB, 1), COEF(NLI, NSUB, 0), (FSSM) ? (bf16*)(ws + WS_HS2) : HA, KP, (float*)(ws + WS_XBUF) + (size_t)(INST) * (M * 8), (unsigned*)(ctl + CW_PCNT) + (INST) * 4096, (LAS float*)(lds + RING_BYTES + 1024), BATCH, NCH, SLD}; pg8::gemm_phase<pg8::EpiResidN<XI16, FSSM>>(lds, g, S, E); } \
        else { pg8::EpiResid<XI16, XO16> E{XSRC, XDST, D, COEF(LI, SUB, 2), SEQ / 256}; pg8::gemm_phase<pg8::EpiResid<XI16, XO16>>(lds, g, S, E); } } \
    if (IN((P) + 2) && PROBE_DUP == 100 + (P) + 2) { pg8::Gemm g{ACT, (const bf16*)(ws + WS_WOUT) + (size_t)(F) * D * FP, M, D, FF, FP, FP, 0}; pg8::StaticOrder S; S.init(M, D, G, bx); \
        pg8::EpiNull E{}; pg8::gemm_phase<pg8::EpiNull>(lds, g, S, E); } \
    SEAM((P) + 2);

    FFN_PHASES(1, 0, 0, 0, xin, xh, false, true, true, FUSE_NORM != 0, 0, 1, 0, false)
    if (!fz) { if (IN(4)) for (int rep = 0; rep < (PROBE_DUP == 4 ? 5 : 1); ++rep) { PHASE_IDS; norm_phase<false>(xh, COEF(0, 1, 1), COEF(0, 1, 0), HA, gw, ngw, lane); }
    SEAM(4); }
    if (IN(5)) for (int rep = 0; rep < NREP(5); ++rep) { pg8::Gemm g{HA, (const bf16*)(ws + WS_WQKV), M, QKVD, D, KP, KP, 0}; pg8::StaticOrder S; S.init(M, QKVD, G, bx, OTH_WGM); S.mrev = QKV_MREV;
        pg8::EpiQKVN E{(bf16*)(ws + WS_QH), (bf16*)(ws + WS_KH), (bf16*)(ws + WS_VH), SEQ, args.in[10], args.in[11], (const float*)(ws + WS_ROPE), (LAS float*)(lds + RING_BYTES + 1024)};
        pg8::gemm_phase<pg8::EpiQKVN>(lds, g, S, E); }
    SEAM(5);
#if ATT_RSA
#if ATT_WVA
    if (IN(7)) for (int rep = 0; rep < NREP(7); ++rep) { PHASE_IDS; attn_phase_wva(args, (char*)lds_raw, lds, bx, G, lane); }
#else
    if (IN(7)) for (int rep = 0; rep < NREP(7); ++rep) attn_phase_rsa(args, (char*)lds_raw, lds, bx, G, rep ? PROBE_ATT : 0);
    SEAM(7);
    if (IN(8)) for (int rep = 0; rep < NREP(8); ++rep) { PHASE_IDS; combine_phase_rsa(args, gw, ngw, lane); }
#endif
#else
    if (IN(7)) for (int rep = 0; rep < NREP(7); ++rep) attn_phase(args, (char*)lds_raw, bx, G);
    SEAM(7);
    if (IN(8)) for (int rep = 0; rep < NREP(8); ++rep) { PHASE_IDS; combine_phase(args, gw, ngw, lane); }
#endif
    SEAM(8);
    if (IN(9)) { pg8::Gemm g{HA, (const bf16*)(ws + WS_WO), M, D, D, KP, KP, 0}; pg8::StaticOrder S; S.init(M, D, G, bx, fz ? 4 : OTH_WGM); S.mrev = OTH_MREV;
        if (fz) { pg8::EpiResidN<true> E{xh, (_Float16*)xh, D, COEF(0, 1, 2), SEQ / 256, COEF(0, 2, 1), COEF(0, 2, 0), HA, KP, (float*)(ws + WS_XBUF) + (size_t)1 * (M * 8), (unsigned*)(ctl + CW_PCNT) + 1 * 4096, (LAS float*)(lds + RING_BYTES + 1024)}; pg8::gemm_phase<pg8::EpiResidN<true>>(lds, g, S, E); }
        else { pg8::EpiResid<true, true> E{xh, xh, D, COEF(0, 1, 2), SEQ / 256}; pg8::gemm_phase<pg8::EpiResid<true, true>>(lds, g, S, E); } }
    SEAM(9);
    FFN_PHASES(10, 1, 0, 2, xh, xh, true, true, FUSE_NORM == 0, FUSE_NORM != 0, 1, 0, 2, false)
    FFN_PHASES(13, 2, 1, 0, xh, xh, true, true, FUSE_NORM == 0, FUSE_SSMN != 0, 1, 1, 3, true)
    if (!(FUSE_SSMN && fz)) { if (IN(16)) for (int rep = 0; rep < NREP(16); ++rep) { PHASE_IDS; norm_phase<true>(xh, COEF(1, 1, 1), COEF(1, 1, 0), (bf16*)(ws + WS_HS2), gw, ngw, lane); }
    SEAM(16); }
    if (IN(17)) for (int rep = 0; rep < NREP(17); ++rep) { pg8::Gemm g{(const bf16*)(ws + WS_HS2), (const bf16*)(ws + WS_SW), SROWS, 256, 256, SLD, 256, 4}; pg8::StaticOrder S; S.init(SROWS, 256, G, bx);
        pg8::EpiState E{(float*)(ws + WS_SLOC)}; pg8::gemm_phase<pg8::EpiState>(lds, g, S, E); }
    if (SSM_CHAIN) { if (IN(17) && IN(18)) { asm volatile("s_waitcnt vmcnt(0)" ::: "memory"); __syncthreads(); } } else SEAM(17);
    if (IN(18)) for (int rep = 0; rep < NREP(18); ++rep) { PHASE_IDS; scan_phase(args, lds, bx, G, tid); }
    if (SSM_CHAIN) { if (IN(18) && IN(19)) { asm volatile("s_waitcnt vmcnt(0)" ::: "memory"); __syncthreads(); } } else SEAM(18);
    if (IN(19)) for (int rep = 0; rep < NREP(19); ++rep) { pg8::Gemm g{(const bf16*)(ws + WS_HS2), (const bf16*)(ws + WS_TV), SROWS, 256, SLD, SLD, SLD, 4}; pg8::StaticOrder S; S.init(SROWS, 256, G, bx);
        pg8::EpiSsmY E{HA, SEQ, KP}; pg8::gemm_phase<pg8::EpiSsmY>(lds, g, S, E); }
    SEAM(19);
    if (IN(20)) { pg8::Gemm g{HA, (const bf16*)(ws + WS_WGLU), M, 2 * D, D, KP, KP, 0}; pg8::StaticOrder S; S.init(M, 2 * D, G, bx, FUSE_GLUN ? 2 : OTH_WGM); S.mrev = OTH_MREV;
        if constexpr (FUSE_GLUN != 0) { pg8::EpiGLUN<true> E{xh, (_Float16*)xh, D, COEF(1, 1, 2), SEQ / 256, COEF(1, 2, 1), COEF(1, 2, 0), HA, KP, (float*)(ws + WS_XBUF) + (size_t)4 * (M * 8), (unsigned*)(ctl + CW_PCNT) + 4 * 4096, (LAS float*)(lds + RING_BYTES + 1024)}; pg8::gemm_phase<pg8::EpiGLUN<true>>(lds, g, S, E); }
        else { pg8::EpiGLU<true, true> E{xh, xh, D, COEF(1, 1, 2), SEQ / 256}; pg8::gemm_phase<pg8::EpiGLU<true, true>>(lds, g, S, E); } }
    SEAM(20);
    FFN_PHASES(21, 3, 1, 2, xh, xo, true, false, FUSE_GLUN == 0, false, 0, 0, 3, false)
#undef IN
#undef SEAM
}

#ifndef MK_PER_PHASE
#define MK_PER_PHASE 0
#endif
extern "C" void kernel_launch(void* const* d_in, const int* in_sizes, int n_in, void* d_out, int out_size, void* d_ws, size_t ws_size, hipStream_t stream) {
    static int grid = 0;
    if (grid == 0) {
        if (n_in != 23 || in_sizes[0] != M * D || out_size != M * D || ws_size < WS_END) { fprintf(stderr, "kernel_launch: unexpected shapes (n_in %d, in0 %d, out %d, ws %zu); nothing launched\n", n_in, n_in > 0 ? in_sizes[0] : -1, out_size, ws_size); grid = -1; return; }
        int dev = 0, cus = 0, per_cu = 0;
        if (hipGetDevice(&dev) != hipSuccess || hipDeviceGetAttribute(&cus, hipDeviceAttributeMultiprocessorCount, dev) != hipSuccess) { grid = -1; return; }
        if (hipFuncSetAttribute((const void*)mk_fwd, hipFuncAttributeMaxDynamicSharedMemorySize, LDS_BYTES) != hipSuccess) { fprintf(stderr, "kernel_launch: hipFuncSetAttribute failed\n"); grid = -1; return; }
        if (hipOccupancyMaxActiveBlocksPerMultiprocessor(&per_cu, (const void*)mk_fwd, NWAVES * 64, LDS_BYTES) != hipSuccess || per_cu < 1) { fprintf(stderr, "kernel_launch: occupancy query says %d blocks per CU\n", per_cu); }
        (void)hipGetLastError();
        grid = cus;
    }
    if (grid < 0) return;
    (void)hipMemsetAsync((char*)d_ws + WS_CTL, 0, CTL_ZERO_BYTES, stream);
    Args a{};
    for (int i = 0; i < 23; ++i) a.in[i] = (const float*)d_in[i];
    a.out = (float*)d_out; a.ws = (unsigned char*)d_ws;
#if MK_PER_PHASE
    for (int p = 0; p < NPH; ++p) { a.ph_lo = p; a.ph_hi = p + 1; hipLaunchKernelGGL(mk_fwd, dim3(grid), dim3(NWAVES * 64), LDS_BYTES, stream, a); }
#else
    a.ph_lo = 0; a.ph_hi = NPH; hipLaunchKernelGGL(mk_fwd, dim3(grid), dim3(NWAVES * 64), LDS_BYTES, stream, a);
#endif
}
```
